# Optimizing an MI355X kernel written in HIP

```python
import math
import jax, jax.numpy as jnp
from jax import lax
import numpy as np

D_MODEL = 1024
BATCH = 8
SEQ = 2048
DEPTH = 4
DEC_BATCH = 128
DEC_SEQ = 1
PAST_LEN = 16384
PAGE_SIZE = 128

D_MIX = D_MODEL
POOL_WIDTH = D_MIX // 4
POOL_WINDOWS = (2, 4, 8, 16)
POOL_GROUPS = len(POOL_WINDOWS)
POOL_GROUP_DIM = POOL_WIDTH // POOL_GROUPS
POOL_BUF = max(POOL_WINDOWS) - 1
DN_WIDTH = D_MIX // 2
DN_HEAD_DIM = 128
DN_HEADS = DN_WIDTH // DN_HEAD_DIM
DN_CONV = 4
DN_CHUNK = 64
CONF_WIDTH = D_MIX - POOL_WIDTH - DN_WIDTH
CONF_HEADS = 4
CONF_HEAD_DIM = CONF_WIDTH // CONF_HEADS
CONF_WIDTH_K = 31
D_FF = 4 * D_MODEL
EPS = 1e-6
OFF_POOL = 0
OFF_QKV = OFF_POOL + POOL_WIDTH
OFF_Z = OFF_QKV + 3 * DN_WIDTH
OFF_B = OFF_Z + DN_WIDTH
OFF_A = OFF_B + DN_HEADS
OFF_GLU = OFF_A + DN_HEADS
N_IN = OFF_GLU + 2 * CONF_WIDTH

kernel_name = 'hybrid_pool_gdn_conformer_decoder_step'


def _rmsnorm(x, g):
    x32 = x.astype(jnp.float32)
    y = x32 * lax.rsqrt(jnp.mean(x32 * x32, axis=-1, keepdims=True) + EPS)
    return (y * g.astype(jnp.float32)).astype(x.dtype)


def _l2norm(x):
    return x * lax.rsqrt(jnp.sum(x * x, axis=-1, keepdims=True) + EPS)


def _causal_dwconv(x_ext, w):
    ch = w.shape[1]
    return lax.conv_general_dilated(x_ext, w[:, None, :].astype(x_ext.dtype), window_strides=(1,),
                                    padding='VALID', dimension_numbers=('NWC', 'WIO', 'NWC'),
                                    feature_group_count=ch)


def _pool_mixer(u_ext, pos0, pool_w, pool_scale):
    B, L, _ = u_ext.shape
    T = L - POOL_BUF
    u32 = u_ext.astype(jnp.float32)
    cs = jnp.pad(jnp.cumsum(u32, axis=1), ((0, 0), (1, 0), (0, 0)))
    pos = pos0 + jnp.arange(T, dtype=jnp.int32)
    means = []
    for gi, w in enumerate(POOL_WINDOWS):
        lo, hi = gi * POOL_GROUP_DIM, (gi + 1) * POOL_GROUP_DIM
        s = cs[:, POOL_BUF + 1:, lo:hi] - cs[:, POOL_BUF + 1 - w:POOL_BUF + 1 - w + T, lo:hi]
        cnt = jnp.minimum(pos + 1, w).astype(jnp.float32)[None, :, None]
        means.append(s / cnt)
    d = (jnp.concatenate(means, axis=-1) - u32[:, POOL_BUF:]).reshape(B, T, POOL_GROUPS, POOL_GROUP_DIM)
    y = jnp.einsum('btgc,gcd->btgd', d, pool_w.astype(jnp.float32)).reshape(B, T, POOL_WIDTH)
    return (y * pool_scale.astype(jnp.float32)).astype(u_ext.dtype)


def _gated_delta(q, k, v, beta, g, s0):
    B, T, H, DK = q.shape
    DV = v.shape[-1]
    C = min(DN_CHUNK, T)
    n = -(-T // C)
    pad = n * C - T
    if pad:
        q, k, v = [jnp.pad(a, ((0, 0), (0, pad), (0, 0), (0, 0))) for a in (q, k, v)]
        beta, g = [jnp.pad(a, ((0, 0), (0, pad), (0, 0))) for a in (beta, g)]

    def chunks(a):
        return jnp.moveaxis(a.reshape((B, n, C) + a.shape[2:]), 3, 1)

    q, k, v, beta, g = [chunks(a) for a in (q, k, v, beta, g)]
    G = jnp.cumsum(g, axis=-1)
    idx = jnp.arange(C)
    incl = idx[:, None] >= idx[None, :]
    strict = idx[:, None] > idx[None, :]
    diff = G[..., :, None] - G[..., None, :]
    decay = jnp.where(incl, jnp.exp(jnp.where(incl, diff, 0.0)), 0.0)
    kk = jnp.einsum('bhncd,bhnsd->bhncs', k, k)
    tmat = jnp.where(strict, beta[..., :, None] * kk * decay, 0.0) + jnp.eye(C, dtype=q.dtype)
    rhs = jnp.concatenate([v * beta[..., None], k * (beta * jnp.exp(G))[..., None]], axis=-1)
    sol = lax.linalg.triangular_solve(tmat, rhs, left_side=True, lower=True, unit_diagonal=True)
    u_base, w_cum = sol[..., :DV], sol[..., DV:]
    qk = jnp.einsum('bhncd,bhnsd->bhncs', q, k) * decay
    q_g = q * jnp.exp(G)[..., None]
    k_tail = k * jnp.exp(G[..., -1:] - G)[..., None]
    g_last = jnp.exp(G[..., -1])

    def step(S, inp):
        u_b, w_c, qk_c, qg_c, kt_c, gl_c = inp
        u = u_b - jnp.einsum('bhcd,bhdv->bhcv', w_c, S)
        o = jnp.einsum('bhcd,bhdv->bhcv', qg_c, S) + jnp.einsum('bhcs,bhsv->bhcv', qk_c, u)
        S = S * gl_c[..., None, None] + jnp.einsum('bhcd,bhcv->bhdv', kt_c, u)
        return S, o

    xs = tuple(jnp.moveaxis(a, 2, 0) for a in (u_base, w_cum, qk, q_g, k_tail, g_last))
    s_new, o = lax.scan(step, s0, xs)
    o = o.transpose(1, 0, 3, 2, 4).reshape(B, n * C, H, DV)[:, :T]
    return o, s_new


def _layer(x, c, pos0, pool_buf, conv_buf, s0, conf_buf, lp):
    (w_ada, b_ada, g_norm1, g_norm2, w_in, pool_w, pool_scale, qkv_conv_w, a_log, dt_bias,
     dn_norm_g, conf_dw_w, conf_dw_b, conf_ln_g, conf_ln_b, conf_pw_w, w_out, w_ff1, w_ff2) = lp
    f32 = jnp.float32
    B, T, _ = x.shape
    mod = jax.nn.silu(c) @ w_ada + b_ada
    shift1, scale1, gate1, shift2, scale2, gate2 = [m[:, None, :] for m in jnp.split(mod, 6, axis=-1)]
    h = _rmsnorm(x, g_norm1) * (1 + scale1) + shift1
    proj = h @ w_in

    pool_ext = jnp.concatenate([pool_buf, proj[..., OFF_POOL:OFF_QKV]], axis=1)
    y_a = _pool_mixer(pool_ext, pos0, pool_w, pool_scale)
    new_pool = pool_ext[:, -POOL_BUF:]

    qkv_ext = jnp.concatenate([conv_buf, proj[..., OFF_QKV:OFF_Z]], axis=1)
    qkv = jax.nn.silu(_causal_dwconv(qkv_ext, qkv_conv_w)).astype(f32)
    new_conv = qkv_ext[:, -(DN_CONV - 1):]
    q, k, v = [a.reshape(B, T, DN_HEADS, DN_HEAD_DIM) for a in jnp.split(qkv, 3, axis=-1)]
    q = _l2norm(q) * (DN_HEAD_DIM ** -0.5)
    k = _l2norm(k)
    beta = jax.nn.sigmoid(proj[..., OFF_B:OFF_A].astype(f32))
    g = -jnp.exp(a_log.astype(f32)) * jax.nn.softplus(proj[..., OFF_A:OFF_GLU].astype(f32) + dt_bias.astype(f32))
    o, s_new = _gated_delta(q, k, v, beta, g, s0.astype(f32))
    z = proj[..., OFF_Z:OFF_B].astype(f32).reshape(B, T, DN_HEADS, DN_HEAD_DIM)
    o = o * lax.rsqrt(jnp.mean(o * o, axis=-1, keepdims=True) + EPS) * dn_norm_g.astype(f32) * jax.nn.silu(z)
    y_b = o.reshape(B, T, DN_WIDTH).astype(x.dtype)

    glu = proj[..., OFF_GLU:OFF_GLU + CONF_WIDTH] * jax.nn.sigmoid(proj[..., OFF_GLU + CONF_WIDTH:])
    conf_ext = jnp.concatenate([conf_buf, glu], axis=1)
    new_conf = conf_ext[:, -(CONF_WIDTH_K - 1):]
    dc = (_causal_dwconv(conf_ext, conf_dw_w) + conf_dw_b).astype(f32).reshape(B, T, CONF_HEADS, CONF_HEAD_DIM)
    mu = jnp.mean(dc, axis=-1, keepdims=True)
    var = jnp.mean(jnp.square(dc - mu), axis=-1, keepdims=True)
    dn = ((dc - mu) * lax.rsqrt(var + EPS)).reshape(B, T, CONF_WIDTH) * conf_ln_g.astype(f32) + conf_ln_b.astype(f32)
    y_c = jax.nn.silu(dn).astype(x.dtype) @ conf_pw_w

    mix = jnp.concatenate([y_a, y_b, y_c], axis=-1) @ w_out
    x = x + gate1 * mix

    hf = _rmsnorm(x, g_norm2) * (1 + scale2) + shift2
    a = jax.nn.relu(hf @ w_ff1)
    x = x + gate2 * ((a * a) @ w_ff2)
    return x, new_pool, new_conv, s_new, new_conf


def setup_inputs(seed: int = 0) -> dict:
    key = jax.random.key(seed)
    ks = iter(jax.random.split(key, 40))

    def nrm(shape, std):
        return jax.random.normal(next(ks), shape, jnp.float32) * std

    def gain(shape):
        return 1.0 + nrm(shape, 0.02)

    x_prompt = nrm((BATCH, SEQ, D_MODEL), 1.0)
    x_sample = nrm((DEC_BATCH, DEC_SEQ, D_MODEL), 1.0)
    state_pool = nrm((DEPTH, DEC_BATCH, POOL_BUF, POOL_WIDTH), 1.0)
    state_qkv_conv = nrm((DEPTH, DEC_BATCH, DN_CONV - 1, 3 * DN_WIDTH), 1.0)
    state_delta = nrm((DEPTH, DEC_BATCH, DN_HEADS, DN_HEAD_DIM, DN_HEAD_DIM), 0.1)
    state_conv = nrm((DEPTH, DEC_BATCH, CONF_WIDTH_K - 1, CONF_WIDTH), 0.5)
    c_prompt = nrm((BATCH, D_MODEL), 1.0)
    c_sample = nrm((DEC_BATCH, D_MODEL), 1.0)
    a_log = jnp.log(jax.random.uniform(next(ks), (DEPTH, DN_HEADS), jnp.float32, 1.0, 16.0))
    dt = jnp.exp(jax.random.uniform(next(ks), (DEPTH, DN_HEADS), jnp.float32, math.log(1e-3), math.log(1e-1)))
    dt_bias = jnp.log(jnp.expm1(dt))
    return {
        'x_prompt': x_prompt, 'x_sample': x_sample,
        'state_pool': state_pool, 'state_qkv_conv': state_qkv_conv,
        'state_delta': state_delta, 'state_conv': state_conv,
        'c_prompt': c_prompt, 'c_sample': c_sample,
        'w_ada': nrm((DEPTH, D_MODEL, 6 * D_MODEL), 0.5 * D_MODEL ** -0.5),
        'b_ada': nrm((DEPTH, 6 * D_MODEL), 0.01),
        'g_norm1': gain((DEPTH, D_MODEL)), 'g_norm2': gain((DEPTH, D_MODEL)),
        'w_in': nrm((DEPTH, D_MODEL, N_IN), D_MODEL ** -0.5),
        'pool_w': nrm((DEPTH, POOL_GROUPS, POOL_GROUP_DIM, POOL_GROUP_DIM), POOL_GROUP_DIM ** -0.5),
        'pool_scale': gain((DEPTH, POOL_WIDTH)),
        'qkv_conv_w': nrm((DEPTH, DN_CONV, 3 * DN_WIDTH), DN_CONV ** -0.5),
        'a_log': a_log, 'dt_bias': dt_bias,
        'dn_norm_g': gain((DEPTH, DN_HEAD_DIM)),
        'conf_dw_w': nrm((DEPTH, CONF_WIDTH_K, CONF_WIDTH), CONF_WIDTH_K ** -0.5),
        'conf_dw_b': nrm((DEPTH, CONF_WIDTH), 0.02),
        'conf_ln_g': gain((DEPTH, CONF_WIDTH)), 'conf_ln_b': nrm((DEPTH, CONF_WIDTH), 0.02),
        'conf_pw_w': nrm((DEPTH, CONF_WIDTH, CONF_WIDTH), CONF_WIDTH ** -0.5),
        'w_out': nrm((DEPTH, D_MIX, D_MODEL), D_MIX ** -0.5),
        'w_ff1': nrm((DEPTH, D_MODEL, D_FF), D_MODEL ** -0.5),
        'w_ff2': nrm((DEPTH, D_FF, D_MODEL), D_FF ** -0.5),
        'g_final': gain((D_MODEL,)),
    }


def reference(x_prompt, x_sample, state_pool, state_qkv_conv, state_delta, state_conv, c_prompt, c_sample,
              w_ada, b_ada, g_norm1, g_norm2, w_in, pool_w, pool_scale, qkv_conv_w, a_log, dt_bias,
              dn_norm_g, conf_dw_w, conf_dw_b, conf_ln_g, conf_ln_b, conf_pw_w, w_out, w_ff1, w_ff2, g_final):
    bp = x_prompt.shape[0]
    dt_ = x_prompt.dtype
    zero_pool = jnp.zeros((bp, POOL_BUF, POOL_WIDTH), dt_)
    zero_conv = jnp.zeros((bp, DN_CONV - 1, 3 * DN_WIDTH), dt_)
    zero_s = jnp.zeros((bp, DN_HEADS, DN_HEAD_DIM, DN_HEAD_DIM), jnp.float32)
    zero_conf = jnp.zeros((bp, CONF_WIDTH_K - 1, CONF_WIDTH), dt_)
    xp, xs = x_prompt, x_sample
    pp, pc, ps, pf = [], [], [], []
    sp, sc, ss, sf = [], [], [], []
    for l in range(DEPTH):
        lp = (w_ada[l], b_ada[l], g_norm1[l], g_norm2[l], w_in[l], pool_w[l], pool_scale[l], qkv_conv_w[l],
              a_log[l], dt_bias[l], dn_norm_g[l], conf_dw_w[l], conf_dw_b[l], conf_ln_g[l], conf_ln_b[l],
              conf_pw_w[l], w_out[l], w_ff1[l], w_ff2[l])
        xp, n_pool, n_conv, n_s, n_conf = _layer(xp, c_prompt, 0, zero_pool, zero_conv, zero_s, zero_conf, lp)
        pp.append(n_pool); pc.append(n_conv); ps.append(n_s); pf.append(n_conf)
        xs, n_pool, n_conv, n_s, n_conf = _layer(xs, c_sample, PAST_LEN, state_pool[l], state_qkv_conv[l],
                                                 state_delta[l], state_conv[l], lp)
        sp.append(n_pool); sc.append(n_conv); ss.append(n_s); sf.append(n_conf)
    y_prompt = _rmsnorm(xp, g_final)
    y_sample = _rmsnorm(xs, g_final)
    return (y_prompt, y_sample,
            jnp.stack(pp), jnp.stack(sp),
            jnp.stack(pc), jnp.stack(sc),
            jnp.stack(ps), jnp.stack(ss),
            jnp.stack(pf), jnp.stack(sf))
```

```cpp
#include <hip/hip_runtime.h>
#include <hip/hip_cooperative_groups.h>
#include <cstdio>
#include <cstdint>
namespace cg = cooperative_groups;

constexpr int D = 1024, NBAT = 8, SEQ = 2048, MP = NBAT * SEQ, NS = 128, MT = MP + NS, MPAD = 16640, DEPTH = 4;
constexpr int NPROJ = 2816, NIN = 2824, FF = 4096, NMOD = 136, MODW = 6 * D;
constexpr int PC_POOL = 0, PC_QKV = 256, PC_Z = 1792, PC_GLU = 2304;
constexpr float EPS = 1e-6f;
__device__ __forceinline__ int bidx_of_row(int row) { return row < MP ? (row >> 11) : (row - MP + NBAT); }

namespace pg8 {
#define PG8_LAS __attribute__((address_space(3)))
typedef unsigned short bf16_t;
typedef short bf16x8 __attribute__((ext_vector_type(8)));
typedef float f32x4 __attribute__((ext_vector_type(4)));
typedef unsigned u32x4 __attribute__((ext_vector_type(4)));
constexpr int BM = 256, BK = 64, HALF = 128, HTB = HALF * BK * 2  , STAGE_BYTES = 8 * HTB, NXCD = 8, WGM = 4;

__host__ __device__ __forceinline__ int lds_byte(int r, int c) { const int st = (r >> 4) * 2 + (c >> 5), rr = r & 15, cc = c & 31, ob = rr * 64 + cc * 2; return st * 1024 + (ob ^ (((ob >> 9) & 1) << 5)); }
__host__ __device__ __forceinline__ void stage_rc(int b, int& R, int& C) { const int st = b / 1024, sb = b % 1024, swz = sb ^ (((sb >> 9) & 1) << 5); R = (st >> 1) * 16 + swz / 64; C = (st & 1) * 32 + (swz % 64) / 2; }
__host__ __device__ __forceinline__ int perm32(int rho) { const int n = rho >> 4, i = rho & 15; return 8 * (i >> 2) + 4 * n + (i & 3); }

struct Unit { int pm, pn; };
struct Gemm { const bf16_t* A; const bf16_t* Bt; int M, N, K; };

struct StaticOrder {
    int nM, nN, nwg, G, c;
    __host__ __device__ void init(int M, int N, int G_, int c_) { nM = M / BM; nN = N / BM; nwg = nM * nN; G = G_; c = c_; }
    __host__ __device__ __forceinline__ bool next(int i, Unit& u) const {
        const long L = (long)i * G + c; if (L >= nwg) return false;
        int wgid = (int)L; { const int q = nwg / NXCD, r = nwg % NXCD, xcd = wgid % NXCD, off = wgid / NXCD; wgid = (xcd < r ? xcd * (q + 1) : r * (q + 1) + (xcd - r) * q) + off; }
        const int nig = WGM * nN, gid = wgid / nig, fm = gid * WGM, gsz = (nM - fm) < WGM ? (nM - fm) : WGM;
        u.pm = fm + ((wgid % nig) % gsz); u.pn = (wgid % nig) / gsz; return true;
    }
    __device__ __forceinline__ void a_ready(const Unit&) const {}
    __device__ __forceinline__ void done(const Unit&) const {}
};

__device__ __forceinline__ unsigned cvt_pk_bf16(float lo, float hi) { unsigned r; asm volatile("v_cvt_pk_bf16_f32 %0, %1, %2" : "=v"(r) : "v"(lo), "v"(hi)); return r; }
template <int ACT, bool IMG = false> struct EpiBf16 {
    static constexpr bool PERM = true, AFTER_DRAIN = false, A_IMG = false;
    bf16_t* O; int ldc;
    __device__ __forceinline__ void operator()(const f32x4 (&acc)[2][2][4][2], const Unit& u, int wr, int wc, int fr, int fq) const {
        const int row0 = u.pm * BM + wr * 64 + fr; const int col0 = u.pn * BM + wc * 32 + 8 * fq;
#pragma unroll
        for (int ai = 0; ai < 2; ++ai)
#pragma unroll
            for (int m = 0; m < 4; ++m) { bf16_t* rowp = IMG ? (bf16_t*)((char*)O + ((size_t)(u.pm * (ldc >> 6) + u.pn * 4 + (wc >> 1)) * 2 + ai) * 16384 + ((wr * 4 + m) * 2 + (wc & 1)) * 1024 + ((fr * 64 + 16 * fq) ^ ((fr >> 3) << 5)))
                                                         : O + (size_t)(row0 + ai * HALF + m * 16) * ldc + col0;
#pragma unroll
                for (int bj = 0; bj < 2; ++bj) { f32x4 v0 = acc[ai][bj][m][0], v1 = acc[ai][bj][m][1];
                    if (ACT == 2) {
#pragma unroll
                        for (int e = 0; e < 4; ++e) { float a = fmaxf(v0[e], 0.f), b = fmaxf(v1[e], 0.f); v0[e] = a * a; v1[e] = b * b; } }
                    u32x4 w; w.x = cvt_pk_bf16(v0[0], v0[1]); w.y = cvt_pk_bf16(v0[2], v0[3]); w.z = cvt_pk_bf16(v1[0], v1[1]); w.w = cvt_pk_bf16(v1[2], v1[3]);
                    *(u32x4*)(rowp + (IMG ? bj * 32768 : bj * HALF)) = w; } }
    }
};
__device__ __forceinline__ void unpack8_bf16(const u32x4 w, f32x4& lo, f32x4& hi) {
    lo[0] = __builtin_bit_cast(float, w.x << 16); lo[1] = __builtin_bit_cast(float, w.x & 0xffff0000u); lo[2] = __builtin_bit_cast(float, w.y << 16); lo[3] = __builtin_bit_cast(float, w.y & 0xffff0000u);
    hi[0] = __builtin_bit_cast(float, w.z << 16); hi[1] = __builtin_bit_cast(float, w.z & 0xffff0000u); hi[2] = __builtin_bit_cast(float, w.w << 16); hi[3] = __builtin_bit_cast(float, w.w & 0xffff0000u);
}
__device__ __forceinline__ u32x4 pack8_bf16(const f32x4 lo, const f32x4 hi) { u32x4 w; w.x = cvt_pk_bf16(lo[0], lo[1]); w.y = cvt_pk_bf16(lo[2], lo[3]); w.z = cvt_pk_bf16(hi[0], hi[1]); w.w = cvt_pk_bf16(hi[2], hi[3]); return w; }
struct EpiResid {
    static constexpr bool PERM = true, AFTER_DRAIN = false, A_IMG = true;
    bf16_t* X; const float* gate;
    __device__ __forceinline__ void operator()(const f32x4 (&acc)[2][2][4][2], const Unit& u, int wr, int wc, int fr, int fq) const {
        const int col0 = u.pn * BM + wc * 32 + 8 * fq; const float* gp = gate + (size_t)(u.pm >> 3) * MODW + col0;
#pragma unroll
        for (int bj = 0; bj < 2; ++bj) { const f32x4 g0 = *(const f32x4*)(gp + bj * HALF), g1 = *(const f32x4*)(gp + bj * HALF + 4);
#pragma unroll
            for (int ai = 0; ai < 2; ++ai)
#pragma unroll
                for (int m = 0; m < 4; ++m) { bf16_t* xp = X + (size_t)(u.pm * BM + ai * HALF + wr * 64 + m * 16 + fr) * D + col0 + bj * HALF;
                    f32x4 x0, x1; unpack8_bf16(*(const u32x4*)xp, x0, x1); x0 = x0 + g0 * acc[ai][bj][m][0]; x1 = x1 + g1 * acc[ai][bj][m][1]; *(u32x4*)xp = pack8_bf16(x0, x1); } }
    }
};
template <int MODE> struct EpiResidNorm {
    static constexpr bool PERM = true, AFTER_DRAIN = true, A_IMG = (MODE == 1);
    bf16_t* X; const float* gate; const float* gvec; const float* mod; bf16_t* XN; float* out; unsigned* xbuf; unsigned* cnt;
    __device__ __forceinline__ void fused(f32x4 (&acc)[2][2][4][2], const Unit& u, int wr, int wc, int fr, int fq, PG8_LAS unsigned char* lds, int wid, int lane) const {
        const int col0 = u.pn * BM + wc * 32 + 8 * fq, b = u.pm >> 3;
        const float* gp = gate + (size_t)b * MODW + col0;
        PG8_LAS float* P = (PG8_LAS float*)lds;
        PG8_LAS float* S = (PG8_LAS float*)(lds + 4096);
        float ssum[2][4];
#pragma unroll
        for (int ai = 0; ai < 2; ++ai)
#pragma unroll
            for (int m = 0; m < 4; ++m) ssum[ai][m] = 0.f;
#pragma unroll
        for (int bj = 0; bj < 2; ++bj) { const f32x4 g0 = *(const f32x4*)(gp + bj * HALF), g1 = *(const f32x4*)(gp + bj * HALF + 4);
#pragma unroll
            for (int ai = 0; ai < 2; ++ai)
#pragma unroll
                for (int m = 0; m < 4; ++m) { bf16_t* xp = X + (size_t)(u.pm * BM + ai * HALF + wr * 64 + m * 16 + fr) * D + col0 + bj * HALF;
                    f32x4 x0, x1; unpack8_bf16(*(const u32x4*)xp, x0, x1); x0 = x0 + g0 * acc[ai][bj][m][0]; x1 = x1 + g1 * acc[ai][bj][m][1];
                    if (MODE == 0) *(u32x4*)xp = pack8_bf16(x0, x1);
                    acc[ai][bj][m][0] = x0; acc[ai][bj][m][1] = x1;
                    ssum[ai][m] += ((x0[0] * x0[0] + x0[1] * x0[1]) + (x0[2] * x0[2] + x0[3] * x0[3])) + ((x1[0] * x1[0] + x1[1] * x1[1]) + (x1[2] * x1[2] + x1[3] * x1[3])); } }
#pragma unroll
        for (int ai = 0; ai < 2; ++ai)
#pragma unroll
            for (int m = 0; m < 4; ++m) { float s = ssum[ai][m]; s += __shfl_xor(s, 16); s += __shfl_xor(s, 32); if (fq == 0) P[(ai * HALF + wr * 64 + m * 16 + fr) * 4 + wc] = s; }
        asm volatile("s_waitcnt lgkmcnt(0)" ::: "memory"); __builtin_amdgcn_s_barrier(); asm volatile("" ::: "memory");
        const int row = wid * 32 + (lane & 31);
        if (lane < 32) { const f32x4 p4 = *(const PG8_LAS f32x4*)(P + row * 4); const float t = (p4[0] + p4[1]) + (p4[2] + p4[3]);
            __hip_atomic_store(xbuf + ((size_t)(u.pm * BM + row) * 4 + u.pn), __builtin_bit_cast(unsigned, t), __ATOMIC_RELAXED, __HIP_MEMORY_SCOPE_AGENT); }
        asm volatile("s_waitcnt vmcnt(0)" ::: "memory");
        if (lane == 0) __hip_atomic_fetch_add(cnt, 1u, __ATOMIC_RELAXED, __HIP_MEMORY_SCOPE_AGENT);
        if (wid == 0) { unsigned sp = 0;
            while ((unsigned)__builtin_amdgcn_readfirstlane(__hip_atomic_load(cnt, __ATOMIC_RELAXED, __HIP_MEMORY_SCOPE_AGENT)) < 32u) { __builtin_amdgcn_s_sleep(2); if (++sp > (1u << 20)) break; }
            __builtin_amdgcn_fence(__ATOMIC_ACQUIRE, "agent"); }
        asm volatile("s_waitcnt vmcnt(0) lgkmcnt(0)" ::: "memory"); __builtin_amdgcn_s_barrier(); asm volatile("" ::: "memory");
        if (lane < 32) { const unsigned* sl = xbuf + (size_t)(u.pm * BM + row) * 4; float tot = 0.f;
#pragma unroll
            for (int t = 0; t < 4; ++t) tot += __builtin_bit_cast(float, __hip_atomic_load(sl + t, __ATOMIC_RELAXED, __HIP_MEMORY_SCOPE_AGENT));
            S[row] = rsqrtf(tot * (1.f / D) + EPS); }
        asm volatile("s_waitcnt lgkmcnt(0)" ::: "memory"); __builtin_amdgcn_s_barrier(); asm volatile("" ::: "memory");
        const float* mp = mod + (size_t)b * MODW + col0;
#pragma unroll
        for (int bj = 0; bj < 2; ++bj) { const int off = bj * HALF;
            f32x4 gs0 = *(const f32x4*)(gvec + col0 + off), gs1 = *(const f32x4*)(gvec + col0 + off + 4), sh0 = (f32x4){0.f, 0.f, 0.f, 0.f}, sh1 = sh0;
            if (MODE == 0) { gs0 = gs0 * (*(const f32x4*)(mp + D + off) + 1.f); gs1 = gs1 * (*(const f32x4*)(mp + D + off + 4) + 1.f); sh0 = *(const f32x4*)(mp + off); sh1 = *(const f32x4*)(mp + off + 4); }
#pragma unroll
            for (int ai = 0; ai < 2; ++ai)
#pragma unroll
                for (int m = 0; m < 4; ++m) { const int rl = ai * HALF + wr * 64 + m * 16 + fr; const float rinv = S[rl]; const size_t o = (size_t)(u.pm * BM + rl) * D + col0 + off;
                    const f32x4 h0 = acc[ai][bj][m][0] * rinv * gs0 + sh0, h1 = acc[ai][bj][m][1] * rinv * gs1 + sh1;
                    if (MODE == 0) *(u32x4*)(XN + o) = pack8_bf16(h0, h1);
                    else { *(f32x4*)(out + o) = h0; *(f32x4*)(out + o + 4) = h1; } } }
    }
};
template <class Epi, class Sched, bool ALIGN_EPI = false, bool SP2 = false>
__device__ __forceinline__ void gemm_phase(PG8_LAS unsigned char* lds, const Gemm g, const Sched& S, const Epi& E) {
    int tid_ = threadIdx.x; asm volatile("" : "+v"(tid_)); const int tid = tid_, wid = __builtin_amdgcn_readfirstlane(tid >> 6), lane = tid & 63, wr = wid >> 2, wc = wid & 3, fr = lane & 15, fq = lane >> 4;
    const int K = g.K, nt = K / BK;
    unsigned voffA[2], voffB[2];
#pragma unroll
    for (int i = 0; i < 2; ++i) { int R, C; stage_rc(tid * 16 + i * 8192, R, C); const int Rb = Epi::PERM ? ((R & ~31) + perm32(R & 31)) : R;
        voffA[i] = Epi::A_IMG ? (unsigned)(tid * 16 + i * 8192) : (unsigned)(R * K + C) * 2u; voffB[i] = (unsigned)(Rb * K + C) * 2u; }
    const size_t kstep = (size_t)(BK * 2);
    const size_t hstep = (size_t)HALF * K * 2;
    const size_t kstepA = Epi::A_IMG ? (size_t)32768 : kstep, hstepA = Epi::A_IMG ? (size_t)16384 : hstep;
    const size_t tstep = 2 * hstep;
    const unsigned ldsw = (unsigned)wid * 1024u;
    const int aoff = lds_byte(wr * 64 + fr, fq * 8), boff = lds_byte(wc * 32 + fr, fq * 8);
#define PG8_SA(b, h) (((b) * 2 + (h)) * HTB)
#define PG8_SB(b, h) ((4 + (b) * 2 + (h)) * HTB)
#define PG8_STAGE(bufoff, gbase, voff) do { _Pragma("unroll") for (int _i = 0; _i < 2; ++_i) \
        __builtin_amdgcn_global_load_lds((const unsigned*)((const char*)(gbase) + (voff)[_i]), (PG8_LAS unsigned*)(lds + (bufoff) + ldsw + _i * 8192), 16, 0, 0); } while (0)
#define PG8_LDA(dst, b, h) do { _Pragma("unroll") for (int m = 0; m < 4; ++m) _Pragma("unroll") for (int k = 0; k < 2; ++k) dst[m][k] = *(const PG8_LAS bf16x8*)(lds + PG8_SA(b, h) + aoff + m * 2048 + k * 1024); } while (0)
#define PG8_LDB(dst, b, h) do { _Pragma("unroll") for (int n = 0; n < 2; ++n) _Pragma("unroll") for (int k = 0; k < 2; ++k) dst[n][k] = *(const PG8_LAS bf16x8*)(lds + PG8_SB(b, h) + boff + n * 2048 + k * 1024); } while (0)
#define PG8_MMA(ai, bj, At, Bt) do { __builtin_amdgcn_s_setprio(1); _Pragma("unroll") for (int m = 0; m < 4; ++m) _Pragma("unroll") for (int n = 0; n < 2; ++n) _Pragma("unroll") for (int k = 0; k < 2; ++k) \
        acc[ai][bj][m][n] = __builtin_amdgcn_mfma_f32_16x16x32_bf16(Bt[n][k], At[m][k], acc[ai][bj][m][n], 0, 0, 0); __builtin_amdgcn_s_setprio(0); } while (0)
#define PG8_WAIT_V(n) asm volatile("s_waitcnt vmcnt(" #n ")" ::: "memory")
#define PG8_WAIT_L(n) asm volatile("s_waitcnt lgkmcnt(" #n ")" ::: "memory")
#define PG8_BAR __builtin_amdgcn_s_barrier()
#define PG8_SCHED __builtin_amdgcn_sched_barrier(0)
    Unit cur, nxt; int ui = 0;
    if (!S.next(0, cur)) return;
    f32x4 acc[2][2][4][2];
#pragma unroll
    for (int a = 0; a < 2; ++a)
#pragma unroll
        for (int b = 0; b < 2; ++b)
#pragma unroll
            for (int m = 0; m < 4; ++m)
#pragma unroll
                for (int n = 0; n < 2; ++n) acc[a][b][m][n] = (f32x4){0.f, 0.f, 0.f, 0.f};
    bf16x8 At[4][2], B0[2][2], B1[2][2];
    const char* cA = (const char*)g.A + (size_t)cur.pm * tstep; const char* cB = (const char*)g.Bt + (size_t)cur.pn * tstep;
    S.a_ready(cur);
    if constexpr (SP2) {
        PG8_STAGE(PG8_SB(0, 0), cB, voffB); PG8_STAGE(PG8_SB(0, 1), cB + hstep, voffB); PG8_STAGE(PG8_SA(0, 0), cA, voffA); PG8_STAGE(PG8_SA(0, 1), cA + hstepA, voffA);
        if (wr == 1) PG8_BAR;
        PG8_WAIT_V(2); PG8_BAR;
        PG8_STAGE(PG8_SB(1, 0), cB + kstep, voffB); PG8_STAGE(PG8_SA(1, 0), cA + kstepA, voffA); PG8_STAGE(PG8_SB(1, 1), cB + hstep + kstep, voffB);
        PG8_WAIT_V(6); PG8_BAR;
    } else {
        PG8_STAGE(PG8_SB(0, 0), cB, voffB); PG8_STAGE(PG8_SA(0, 0), cA, voffA); PG8_STAGE(PG8_SB(0, 1), cB + hstep, voffB); PG8_STAGE(PG8_SA(0, 1), cA + hstepA, voffA);
        if (wr == 1) PG8_BAR;
        PG8_WAIT_V(4); PG8_BAR;
        PG8_STAGE(PG8_SB(1, 0), cB + kstep, voffB); PG8_STAGE(PG8_SA(1, 0), cA + kstepA, voffA); PG8_STAGE(PG8_SB(1, 1), cB + hstep + kstep, voffB);
        PG8_WAIT_V(6); PG8_BAR;
    }
    for (;;) {
        const bool has_next = S.next(ui + 1, nxt);
        const char* nA = has_next ? (const char*)g.A + (size_t)nxt.pm * tstep : cA; const char* nB = has_next ? (const char*)g.Bt + (size_t)nxt.pn * tstep : cB;
        for (int t = 0; t < nt; t += 2) {
            const bool last = (t == nt - 2);
            const char* a1 = cA + (size_t)(t + 1) * kstepA;
            const char* a2 = last ? nA : cA + (size_t)(t + 2) * kstepA; const char* b2 = last ? nB : cB + (size_t)(t + 2) * kstep;
            const char* a3 = a2 + kstepA; const char* b3 = b2 + kstep;
            if (last && has_next) S.a_ready(nxt);
            if constexpr (SP2) {
            PG8_LDB(B0, 0, 0); PG8_LDB(B1, 0, 1); PG8_SCHED; PG8_LDA(At, 0, 0); PG8_STAGE(PG8_SA(1, 1), a1 + hstepA, voffA);
            PG8_WAIT_V(8); PG8_WAIT_L(0); PG8_BAR; PG8_MMA(0, 0, At, B0); PG8_MMA(0, 1, At, B1); PG8_BAR; PG8_SCHED;
            PG8_LDA(At, 0, 1); PG8_STAGE(PG8_SB(0, 0), b2, voffB); PG8_STAGE(PG8_SB(0, 1), b2 + hstep, voffB); PG8_STAGE(PG8_SA(0, 0), a2, voffA);
            PG8_WAIT_V(8); PG8_WAIT_L(0); PG8_BAR; PG8_MMA(1, 0, At, B0); PG8_MMA(1, 1, At, B1); PG8_BAR; PG8_SCHED;
            PG8_LDB(B0, 1, 0); PG8_LDB(B1, 1, 1); PG8_SCHED; PG8_LDA(At, 1, 0); PG8_STAGE(PG8_SA(0, 1), a2 + hstepA, voffA);
            PG8_WAIT_V(8); PG8_WAIT_L(0); PG8_BAR; PG8_MMA(0, 0, At, B0); PG8_MMA(0, 1, At, B1); PG8_BAR; PG8_SCHED;
            PG8_LDA(At, 1, 1); PG8_STAGE(PG8_SB(1, 0), b3, voffB); PG8_STAGE(PG8_SB(1, 1), b3 + hstep, voffB); PG8_STAGE(PG8_SA(1, 0), a3, voffA);
            PG8_WAIT_V(8); PG8_WAIT_L(0); PG8_BAR; PG8_MMA(1, 0, At, B0); PG8_MMA(1, 1, At, B1); PG8_BAR; PG8_SCHED;
            } else {
            PG8_LDB(B0, 0, 0); PG8_SCHED; PG8_LDA(At, 0, 0); PG8_STAGE(PG8_SA(1, 1), a1 + hstepA, voffA);
            PG8_WAIT_L(8); PG8_BAR; PG8_WAIT_L(0); PG8_MMA(0, 0, At, B0); PG8_BAR; PG8_SCHED;
            PG8_LDB(B1, 0, 1); PG8_STAGE(PG8_SB(0, 0), b2, voffB);
            PG8_BAR; PG8_WAIT_L(0); PG8_MMA(0, 1, At, B1); PG8_BAR;
            PG8_LDA(At, 0, 1); PG8_STAGE(PG8_SA(0, 0), a2, voffA);
            PG8_BAR; PG8_WAIT_L(0); PG8_MMA(1, 0, At, B0); PG8_BAR; PG8_SCHED;
            PG8_STAGE(PG8_SB(0, 1), b2 + hstep, voffB);
            PG8_WAIT_V(6); PG8_BAR; PG8_MMA(1, 1, At, B1); PG8_BAR;
            PG8_LDB(B0, 1, 0); PG8_SCHED; PG8_LDA(At, 1, 0); PG8_STAGE(PG8_SA(0, 1), a2 + hstepA, voffA);
            PG8_WAIT_L(8); PG8_BAR; PG8_WAIT_L(0); PG8_MMA(0, 0, At, B0); PG8_BAR; PG8_SCHED;
            PG8_LDB(B1, 1, 1); PG8_STAGE(PG8_SB(1, 0), b3, voffB);
            PG8_BAR; PG8_WAIT_L(0); PG8_MMA(0, 1, At, B1); PG8_BAR;
            PG8_LDA(At, 1, 1); PG8_STAGE(PG8_SA(1, 0), a3, voffA);
            PG8_BAR; PG8_WAIT_L(0); PG8_MMA(1, 0, At, B0); PG8_BAR; PG8_SCHED;
            PG8_STAGE(PG8_SB(1, 1), b3 + hstep, voffB);
            PG8_WAIT_V(6); PG8_BAR; PG8_MMA(1, 1, At, B1); PG8_BAR;
            }
        }
        if constexpr (ALIGN_EPI) { if (wr == 0) PG8_BAR; }
        if constexpr (!Epi::AFTER_DRAIN) { E(acc, cur, wr, wc, fr, fq); S.done(cur); }
        if (!has_next) break;
#pragma unroll
        for (int a = 0; a < 2; ++a)
#pragma unroll
            for (int b = 0; b < 2; ++b)
#pragma unroll
                for (int m = 0; m < 4; ++m)
#pragma unroll
                    for (int n = 0; n < 2; ++n) acc[a][b][m][n] = (f32x4){0.f, 0.f, 0.f, 0.f};
        cur = nxt; cA = nA; cB = nB; ++ui;
        if constexpr (ALIGN_EPI) { if (wr == 1) PG8_BAR; }
    }
    PG8_WAIT_V(0);
    if constexpr (!ALIGN_EPI) { if (wr == 0) PG8_BAR; }
    PG8_BAR;
    if constexpr (Epi::AFTER_DRAIN) { E.fused(acc, cur, wr, wc, fr, fq, lds, wid, lane); S.done(cur); }
#undef PG8_SA
#undef PG8_SB
#undef PG8_STAGE
#undef PG8_LDA
#undef PG8_LDB
#undef PG8_MMA
#undef PG8_WAIT_V
#undef PG8_WAIT_L
#undef PG8_BAR
#undef PG8_SCHED
}
}

#define LAS __attribute__((address_space(3)))
typedef unsigned short bf16;
typedef short bf16x8 __attribute__((ext_vector_type(8)));
typedef float f32x4 __attribute__((ext_vector_type(4)));
typedef unsigned u32x4 __attribute__((ext_vector_type(4)));
typedef unsigned u32x2 __attribute__((ext_vector_type(2)));
constexpr int NWAVES = 8, NTHR = 512;
constexpr size_t MiB = 1u << 20;
constexpr size_t WS_CTL = 0, CTL_ZERO_BYTES = 1 * MiB;
constexpr size_t WS_WIN = 2 * MiB, WS_WOUT = 24 * MiB, WS_W1 = 32 * MiB, WS_W2 = 64 * MiB;
constexpr size_t WS_PWT = 96 * MiB, WS_POOLWT = 96 * MiB + 512 * 1024, WS_SC = 97 * MiB, WS_GLAST = 97 * MiB + 512 * 1024;
constexpr size_t WS_MOD = 98 * MiB, WS_BA = 111 * MiB, WS_X = 112 * MiB, WS_XS = 150 * MiB  , WS_XN = 177 * MiB, WS_MIX = 210 * MiB, WS_PROJ = 243 * MiB, WS_PREP = 333 * MiB, WS_H = 243 * MiB, WS_HS = 421 * MiB, WS_SCR = 422 * MiB, WS_XCH = 423 * MiB  , WS_END = 425 * MiB;
constexpr size_t WIN_L = (size_t)NPROJ * D * 2, WOUT_L = (size_t)D * D * 2, W1_L = (size_t)FF * D * 2, W2_L = (size_t)D * FF * 2;
constexpr int PREP_UNIT = 90112, PU_NWC = 0, PU_QG = 16384, PU_QK = 32768, PU_KTT = 40960, PU_UB = 57344;
static_assert(WS_WIN + 4 * WIN_L <= WS_WOUT && WS_MOD + (size_t)DEPTH * NMOD * MODW * 4 <= WS_BA && WS_BA + (size_t)MPAD * 8 * 4 <= WS_X && WS_X + (size_t)MPAD * D * 4 <= WS_XN, "ws map 1");
static_assert(WS_XN + (size_t)MPAD * D * 2 <= WS_MIX && WS_MIX + (size_t)MPAD * D * 2 <= WS_PROJ && WS_PROJ + (size_t)MPAD * NPROJ * 2 <= WS_PREP && WS_PREP + (size_t)1024 * PREP_UNIT <= WS_HS && WS_H + (size_t)MPAD * FF * 2 <= WS_END, "ws map 2");
constexpr int LDS_BYTES = 155648, RING_BYTES = 131072;

constexpr size_t O_YP = 0, O_YS = O_YP + (size_t)MP * D, O_POOLP = O_YS + (size_t)NS * D, O_POOLS = O_POOLP + (size_t)DEPTH * NBAT * 15 * 256, O_QCP = O_POOLS + (size_t)DEPTH * NS * 15 * 256,
    O_QCS = O_QCP + (size_t)DEPTH * NBAT * 3 * 1536, O_DP = O_QCS + (size_t)DEPTH * NS * 3 * 1536, O_DS = O_DP + (size_t)DEPTH * NBAT * 4 * 128 * 128, O_CP = O_DS + (size_t)DEPTH * NS * 4 * 128 * 128,
    O_CS = O_CP + (size_t)DEPTH * NBAT * 30 * 256, O_END = O_CS + (size_t)DEPTH * NS * 30 * 256;
static_assert(O_END == 61333504, "out size");

enum { I_XP = 0, I_XS, I_SPOOL, I_SQKV, I_SDELTA, I_SCONV, I_CP, I_CS, I_WADA, I_BADA, I_G1, I_G2, I_WIN, I_POOLW, I_POOLSC, I_QKVW, I_ALOG, I_DTB, I_DNG, I_CDWW, I_CDWB, I_CLNG, I_CLNB, I_CPW, I_WOUT, I_W1, I_W2, I_GF, N_INPUTS };
struct Args { const float* in[N_INPUTS]; float* out; unsigned char* ws; int ph_lo, ph_hi; };
struct InTbl { const __attribute__((address_space(3))) unsigned* t;
    __device__ __forceinline__ const float* operator[](int i) const { const unsigned lo = __builtin_amdgcn_readfirstlane(t[2 * i]), hi = __builtin_amdgcn_readfirstlane(t[2 * i + 1]); return (const float*)(((unsigned long long)hi << 32) | lo); } };
#ifndef USE_LDS_PTRS
#define USE_LDS_PTRS 0
#endif
#if USE_LDS_PTRS
struct ArgsD { InTbl in; float* out; unsigned char* ws; };
#else
typedef Args ArgsD;
#endif

typedef __bf16 bf16v2_t __attribute__((ext_vector_type(2)));
typedef float f32v2_t __attribute__((ext_vector_type(2)));
__device__ __forceinline__ unsigned cvtpk(float lo, float hi) { bf16v2_t r = __builtin_convertvector((f32v2_t){lo, hi}, bf16v2_t); return __builtin_bit_cast(unsigned, r); }
__device__ __forceinline__ bf16 f2bf(float f) { return (bf16)(cvtpk(f, 0.f) & 0xffffu); }
__device__ __forceinline__ float bf2f(bf16 v) { return __uint_as_float(((unsigned)v) << 16); }
__device__ __forceinline__ float sigmoidf_(float x) { return __builtin_amdgcn_rcpf(1.f + __expf(-x)); }
__device__ __forceinline__ float softplusf_(float x) { return fmaxf(x, 0.f) + __logf(1.f + __expf(-fabsf(x))); }
__device__ __forceinline__ float siluf_(float x) { return x * __builtin_amdgcn_rcpf(1.f + __expf(-x)); }
template <int CTRL> __device__ __forceinline__ float dpp_add(float v) { return v + __builtin_bit_cast(float, __builtin_amdgcn_update_dpp(0, __builtin_bit_cast(int, v), CTRL, 0xf, 0xf, false)); }
__device__ __forceinline__ float wave_sum(float v) {
    v = dpp_add<0xB1>(v); v = dpp_add<0x4E>(v); v = dpp_add<0x141>(v); v = dpp_add<0x140>(v);
    const int iv = __builtin_bit_cast(int, v);
    const float r0 = __builtin_bit_cast(float, __builtin_amdgcn_readlane(iv, 0)), r1 = __builtin_bit_cast(float, __builtin_amdgcn_readlane(iv, 16));
    const float r2 = __builtin_bit_cast(float, __builtin_amdgcn_readlane(iv, 32)), r3 = __builtin_bit_cast(float, __builtin_amdgcn_readlane(iv, 48));
    return (r0 + r1) + (r2 + r3);
}
__device__ __forceinline__ float xreduce64(const float (&v)[64], int lane) {
    float a[32], b[16], c[8], d[4], e[2];
#pragma unroll
    for (int i = 0; i < 32; ++i) { const bool hi = lane & 32; const float keep = hi ? v[i + 32] : v[i], send = hi ? v[i] : v[i + 32]; a[i] = keep + __shfl_xor(send, 32); }
#pragma unroll
    for (int i = 0; i < 16; ++i) { const bool hi = lane & 16; const float keep = hi ? a[i + 16] : a[i], send = hi ? a[i] : a[i + 16]; b[i] = keep + __shfl_xor(send, 16); }
#pragma unroll
    for (int i = 0; i < 8; ++i) { const bool hi = lane & 8; const float keep = hi ? b[i + 8] : b[i], send = hi ? b[i] : b[i + 8]; c[i] = keep + __shfl_xor(send, 8); }
#pragma unroll
    for (int i = 0; i < 4; ++i) { const bool hi = lane & 4; const float keep = hi ? c[i + 4] : c[i], send = hi ? c[i] : c[i + 4]; d[i] = keep + __shfl_xor(send, 4); }
#pragma unroll
    for (int i = 0; i < 2; ++i) { const bool hi = lane & 2; const float keep = hi ? d[i + 2] : d[i], send = hi ? d[i] : d[i + 2]; e[i] = keep + __shfl_xor(send, 2); }
    { const bool hi = lane & 1; const float keep = hi ? e[1] : e[0], send = hi ? e[0] : e[1]; return keep + __shfl_xor(send, 1); }
}
__device__ __forceinline__ bf16x8 mk8(u32x2 lo, u32x2 hi) { u32x4 t; t.x = lo.x; t.y = lo.y; t.z = hi.x; t.w = hi.y; return __builtin_bit_cast(bf16x8, t); }
__device__ __forceinline__ bf16x8 pack8(const f32x4 a, const f32x4 b) { u32x4 t; t.x = cvtpk(a[0], a[1]); t.y = cvtpk(a[2], a[3]); t.z = cvtpk(b[0], b[1]); t.w = cvtpk(b[2], b[3]); return __builtin_bit_cast(bf16x8, t); }
#define MFMA16(a, b, c) __builtin_amdgcn_mfma_f32_16x16x32_bf16((a), (b), (c), 0, 0, 0)

__device__ __forceinline__ void transpose_item(const float* W, int ldw, int ncols, int K, bf16* WT, int row_off, LAS float* scr, int item, int lane) {
    const int nblk = ncols / 32, kb = item / nblk, nb = item % nblk, k0 = 64 * kb, n0 = 32 * nb;
#pragma unroll 8
    for (int i = 0; i < 32; ++i) { const int kk = 2 * i + (lane >> 5); scr[kk * 33 + (lane & 31)] = W[(size_t)(k0 + kk) * ldw + n0 + (lane & 31)]; }
    asm volatile("s_waitcnt lgkmcnt(0)" ::: "memory");
    const int c = lane & 7;
#pragma unroll
    for (int j = 0; j < 4; ++j) { const int n = (lane >> 3) + 8 * j; const LAS float* s = scr + (8 * c) * 33 + n;
        u32x4 o; o.x = cvtpk(s[0 * 33], s[1 * 33]); o.y = cvtpk(s[2 * 33], s[3 * 33]); o.z = cvtpk(s[4 * 33], s[5 * 33]); o.w = cvtpk(s[6 * 33], s[7 * 33]);
        *(u32x4*)(WT + (size_t)(row_off + n0 + n) * K + k0 + 8 * c) = o; }
    asm volatile("s_waitcnt lgkmcnt(0)" ::: "memory");
}
__device__ __forceinline__ void p0a_weights(const ArgsD& a, LAS unsigned char* lds, int l, int gw, int NGW, int lane, int wave) {
    LAS float* scr = (LAS float*)(lds + wave * 16384);
    unsigned char* ws = a.ws;
    constexpr int I_IN1 = 16 * 72, I_IN2 = 16 * 16, I_OUT = 16 * 32, I_1 = 16 * 128, I_2 = 64 * 32, I_PW = 4 * 8, I_PL = 8;
    constexpr int PER = I_IN1 + I_IN2 + I_OUT + I_1 + I_2 + I_PW + I_PL;
    for (int it = gw; it < PER; it += NGW) {
        int r = it;
        const float* win = a.in[I_WIN] + (size_t)l * D * NIN;
        if (r < I_IN1) { transpose_item(win, NIN, 2304, D, (bf16*)(ws + WS_WIN + l * WIN_L), 0, scr, r, lane); continue; } r -= I_IN1;
        if (r < I_IN2) { transpose_item(win + 2312, NIN, 512, D, (bf16*)(ws + WS_WIN + l * WIN_L), 2304, scr, r, lane); continue; } r -= I_IN2;
        if (r < I_OUT) { transpose_item(a.in[I_WOUT] + (size_t)l * D * D, D, D, D, (bf16*)(ws + WS_WOUT + l * WOUT_L), 0, scr, r, lane); continue; } r -= I_OUT;
        if (r < I_1) { transpose_item(a.in[I_W1] + (size_t)l * D * FF, FF, FF, D, (bf16*)(ws + WS_W1 + l * W1_L), 0, scr, r, lane); continue; } r -= I_1;
        if (r < I_2) { transpose_item(a.in[I_W2] + (size_t)l * FF * D, D, D, FF, (bf16*)(ws + WS_W2 + l * W2_L), 0, scr, r, lane); continue; } r -= I_2;
        if (r < I_PW) { transpose_item(a.in[I_CPW] + (size_t)l * 256 * 256, 256, 256, 256, (bf16*)(ws + WS_PWT) + (size_t)l * 65536, 0, scr, r, lane); continue; } r -= I_PW;
        { const int g = r >> 1; transpose_item(a.in[I_POOLW] + (size_t)(l * 4 + g) * 4096, 64, 64, 64, (bf16*)(ws + WS_POOLWT) + (size_t)(l * 4 + g) * 4096, 0, scr, r & 1, lane); }
    }
}
__device__ __forceinline__ void phase_p0a(const ArgsD& a, LAS unsigned char* lds, int tid, int lane, int wave, int G) {
    unsigned char* ws = a.ws;
    p0a_weights(a, lds, 0, blockIdx.x * NWAVES + wave, G * NWAVES, lane, wave);
    const int gt = blockIdx.x * NTHR + tid, NGT = G * NTHR;
    for (int i = gt; i < 144 * 512; i += NGT) { const int r = i >> 9, k = (i & 511) * 2; float v0 = 0.f, v1 = 0.f;
        if (r < NMOD) { const float* cp = r < NBAT ? a.in[I_CP] + (size_t)r * D : a.in[I_CS] + (size_t)(r - NBAT) * D; v0 = siluf_(cp[k]); v1 = siluf_(cp[k + 1]); }
        ((unsigned*)(ws + WS_SC))[i] = cvtpk(v0, v1); }
    for (int i = gt; i < (MPAD - MT) * D / 2; i += NGT) ((unsigned*)(ws + WS_MIX + (size_t)MT * D * 2))[i] = 0u;
}
__device__ __forceinline__ void phase_p0b(const ArgsD& a, int tid, int lane, int wave, int G) {
    const bf16* SC = (const bf16*)(a.ws + WS_SC); float* MOD = (float*)(a.ws + WS_MOD);
    const int q = lane >> 4, c = lane & 15, ct = wave & 3, rt0 = wave >> 2;
    for (int u = blockIdx.x; u < DEPTH * 96; u += G) {
        const int l = u / 96, n0 = (u % 96) * 64 + ct * 16;
        const float* W = a.in[I_WADA] + (size_t)l * D * MODW + n0 + c;
        f32x4 acc[5];
#pragma unroll
        for (int i = 0; i < 5; ++i) acc[i] = (f32x4){0.f, 0.f, 0.f, 0.f};
#pragma unroll 2
        for (int ks = 0; ks < 32; ++ks) {
            const float* wp = W + (size_t)(ks * 32 + q * 8) * MODW;
            float w[8];
#pragma unroll
            for (int j = 0; j < 8; ++j) w[j] = wp[(size_t)j * MODW];
            u32x4 bt; bt.x = cvtpk(w[0], w[1]); bt.y = cvtpk(w[2], w[3]); bt.z = cvtpk(w[4], w[5]); bt.w = cvtpk(w[6], w[7]);
            const bf16x8 bfr = __builtin_bit_cast(bf16x8, bt);
#pragma unroll
            for (int i = 0; i < 5; ++i) { const int rt = rt0 + 2 * i; if (rt < 9) { const bf16x8 af = *(const bf16x8*)(SC + (size_t)(rt * 16 + c) * D + ks * 32 + q * 8); acc[i] = MFMA16(af, bfr, acc[i]); } }
        }
        const float bias = a.in[I_BADA][(size_t)l * MODW + n0 + c];
#pragma unroll
        for (int i = 0; i < 5; ++i) { const int rt = rt0 + 2 * i;
#pragma unroll
            for (int r = 0; r < 4; ++r) { const int row = rt * 16 + q * 4 + r; if (rt < 9 && row < NMOD) MOD[((size_t)l * NMOD + row) * MODW + n0 + c] = acc[i][r] + bias; } }
    }
}
template <bool FIRST, bool WITH_BA>
__device__ __forceinline__ void phase_norm(const ArgsD& a, LAS unsigned char* lds, int l, int modoff, const float* gvec, int nrows, int tid, int lane, int wave, int G) {
    unsigned char* ws = a.ws;
    bf16* XB = (bf16*)(ws + WS_X); float* XS = (float*)(ws + WS_XS); bf16* XN = (bf16*)(ws + WS_XN); float* BA = (float*)(ws + WS_BA);
    const float* MOD = (const float*)(ws + WS_MOD) + (size_t)l * NMOD * MODW + modoff;
    LAS float* wb = (LAS float*)lds;
    if (WITH_BA) {
        const float* win = a.in[I_WIN] + (size_t)l * D * NIN + 2304;
        for (int i = tid; i < 8 * D; i += NTHR) { const int k = i >> 3, cc = i & 7; wb[cc * D + k] = win[(size_t)k * NIN + cc]; }
        __syncthreads();
    }
    f32x4 gv[4];
#pragma unroll
    for (int j = 0; j < 4; ++j) gv[j] = *(const f32x4*)(gvec + 4 * lane + 256 * j);
    f32x4 v[4], vn[4], sh[4], gs[4];
#define NORM_LDROW(dst, r_) do { const int rr_ = (r_) < nrows ? (r_) : nrows - 1; \
        if (FIRST || rr_ >= MP) { const float* xr_ = FIRST ? (rr_ < MP ? a.in[I_XP] + (size_t)rr_ * D : a.in[I_XS] + (size_t)(rr_ - MP) * D) : XS + (size_t)(rr_ - MP) * D; \
            _Pragma("unroll") for (int j = 0; j < 4; ++j) dst[j] = *(const f32x4*)(xr_ + 4 * lane + 256 * j); } \
        else { const bf16* xb_ = XB + (size_t)rr_ * D; \
            _Pragma("unroll") for (int j = 0; j < 4; ++j) { const u32x2 w_ = *(const u32x2*)(xb_ + 4 * lane + 256 * j); dst[j] = (f32x4){__uint_as_float(w_.x << 16), __uint_as_float(w_.x & 0xffff0000u), __uint_as_float(w_.y << 16), __uint_as_float(w_.y & 0xffff0000u)}; } } } while (0)
#define NORM_LDMOD(r_) do { const float* mp_ = MOD + (size_t)bidx_of_row(r_) * MODW; \
        _Pragma("unroll") for (int j = 0; j < 4; ++j) { sh[j] = *(const f32x4*)(mp_ + 4 * lane + 256 * j); gs[j] = gv[j] * (*(const f32x4*)(mp_ + D + 4 * lane + 256 * j) + 1.f); } } while (0)
#define NORM_ROW(row_) do { \
        float s = 0.f; \
        _Pragma("unroll") for (int j = 0; j < 4; ++j) s += (v[j][0] * v[j][0] + v[j][1] * v[j][1]) + (v[j][2] * v[j][2] + v[j][3] * v[j][3]); \
        if (FIRST) { \
            if ((row_) < MP) { _Pragma("unroll") for (int j = 0; j < 4; ++j) *(u32x2*)(XB + (size_t)(row_) * D + 4 * lane + 256 * j) = (u32x2){cvtpk(v[j][0], v[j][1]), cvtpk(v[j][2], v[j][3])}; } \
            else { _Pragma("unroll") for (int j = 0; j < 4; ++j) *(f32x4*)(XS + (size_t)((row_) - MP) * D + 4 * lane + 256 * j) = v[j]; } } \
        const float rinv = rsqrtf(wave_sum(s) * (1.f / D) + EPS); \
        u32x2* o8 = (u32x2*)(XN + (size_t)(row_) * D) + lane; \
        float ba[8]; \
        _Pragma("unroll") for (int e = 0; e < 8; ++e) ba[e] = 0.f; \
        _Pragma("unroll") for (int j = 0; j < 4; ++j) { \
            const f32x4 h = v[j] * rinv * gs[j] + sh[j]; \
            o8[64 * j] = (u32x2){cvtpk(h[0], h[1]), cvtpk(h[2], h[3])}; \
            if (WITH_BA) { _Pragma("unroll") for (int e = 0; e < 8; ++e) { const f32x4 w4 = *(const LAS f32x4*)(wb + e * D + 4 * lane + 256 * j); ba[e] += (h[0] * w4[0] + h[1] * w4[1]) + (h[2] * w4[2] + h[3] * w4[3]); } } } \
        if (WITH_BA) { \
            _Pragma("unroll") for (int e = 0; e < 8; ++e) ba[e] = wave_sum(ba[e]); \
            float outv = ba[0]; \
            _Pragma("unroll") for (int e = 1; e < 8; ++e) outv = (lane == e) ? ba[e] : outv; \
            if (lane < 8) BA[(size_t)(row_) * 8 + lane] = outv; } } while (0)
    for (int r0 = (blockIdx.x * NWAVES + wave) * 8; r0 < MP; r0 += G * NWAVES * 8) {
        NORM_LDMOD(r0);
        NORM_LDROW(vn, r0);
#pragma unroll 1
        for (int i = 0; i < 8; ++i) {
#pragma unroll
            for (int j = 0; j < 4; ++j) v[j] = vn[j];
            if (i < 7) NORM_LDROW(vn, r0 + i + 1);
            NORM_ROW(r0 + i);
        }
    }
    for (int row = MP + blockIdx.x * NWAVES + wave; row < nrows; row += G * NWAVES) {
        NORM_LDMOD(row);
        NORM_LDROW(v, row);
        NORM_ROW(row);
    }
#undef NORM_LDROW
#undef NORM_LDMOD
#undef NORM_ROW
    if (WITH_BA) __syncthreads();
}
__device__ __forceinline__ void phase_final(const ArgsD& a, int lane, int wave, int G) {
    const float* X = (const float*)(a.ws + WS_XS) - (size_t)MP * D; const float* gf = a.in[I_GF];
    f32x4 gv[4];
#pragma unroll
    for (int j = 0; j < 4; ++j) gv[j] = *(const f32x4*)(gf + 4 * lane + 256 * j);
    for (int row = MP + blockIdx.x * NWAVES + wave; row < MT; row += G * NWAVES) {
        const float* xr = X + (size_t)row * D; f32x4 v[4]; float s = 0.f;
#pragma unroll
        for (int j = 0; j < 4; ++j) { v[j] = *(const f32x4*)(xr + 4 * lane + 256 * j); s += (v[j][0] * v[j][0] + v[j][1] * v[j][1]) + (v[j][2] * v[j][2] + v[j][3] * v[j][3]); }
        const float rinv = rsqrtf(wave_sum(s) * (1.f / D) + EPS);
#pragma unroll
        for (int j = 0; j < 4; ++j) *(f32x4*)(a.out + O_YP + (size_t)row * D + 4 * lane + 256 * j) = v[j] * rinv * gv[j];
    }
}

__device__ __forceinline__ int kpos(int k) { return (k & ~31) | (8 * ((k >> 2) & 3) + 4 * ((k >> 4) & 1) + (k & 3)); }
__device__ __forceinline__ int swz256(int row, int e) { return ((((e >> 3) ^ row) & 15) << 3) | (e & 7); }
__device__ __forceinline__ int swz128(int row, int e) { return ((((e >> 3) ^ (row >> 1)) & 7) << 3) | (e & 7); }
constexpr int P2_STGP = 1056, P2_TT = 0, P2_QKT = 18432, P2_QK = 71040, P2_SC = 144768;
template <int NOCT_LOG2, int NITER>
__device__ __forceinline__ void stage_rows(const bf16* pseq, int tfirst, int nrows, int col0, LAS unsigned char* dst, int pitch, int tid) {
    const int total = nrows << NOCT_LOG2;
    u32x4 v[NITER];
#pragma unroll
    for (int i = 0; i < NITER; ++i) { int it = tid + NTHR * i; it = it < total ? it : total - 1; const int r = it >> NOCT_LOG2, o = it & ((1 << NOCT_LOG2) - 1); const int t = tfirst + r, tc = t < 0 ? 0 : t;
        v[i] = *(const u32x4*)(pseq + (size_t)tc * NPROJ + col0 + 8 * o); if (t < 0) v[i] = (u32x4){0u, 0u, 0u, 0u}; }
#pragma unroll
    for (int i = 0; i < NITER; ++i) { const int it = tid + NTHR * i; if (it < total) { const int r = it >> NOCT_LOG2, o = it & ((1 << NOCT_LOG2) - 1); *(LAS u32x4*)(dst + r * pitch + o * 16) = v[i]; } }
}
__device__ __forceinline__ void unpack8(const u32x2 lo, const u32x2 hi, float (&f)[8]) {
    f[0] = __uint_as_float(lo.x << 16); f[1] = __uint_as_float(lo.x & 0xffff0000u); f[2] = __uint_as_float(lo.y << 16); f[3] = __uint_as_float(lo.y & 0xffff0000u);
    f[4] = __uint_as_float(hi.x << 16); f[5] = __uint_as_float(hi.x & 0xffff0000u); f[6] = __uint_as_float(hi.y << 16); f[7] = __uint_as_float(hi.y & 0xffff0000u);
}
__device__ __forceinline__ void prep_unit(const ArgsD& a, LAS unsigned char* lds, int l, int b, int n, int hp, int tid, int lane) {
    unsigned char* ws = a.ws;
    const bf16* pseq = (const bf16*)(ws + WS_PROJ) + (size_t)(b * SEQ) * NPROJ; const float* BA = (const float*)(ws + WS_BA);
    const int half = tid >> 8, ht = tid & 255, h0 = 2 * hp, h = h0 + half, t0 = 64 * n, row0 = b * SEQ + t0;
    const int unit = (b * 32 + n) * 4 + h;
    unsigned char* pu = ws + WS_PREP + (size_t)unit * PREP_UNIT;
    LAS bf16* qh = (LAS bf16*)(lds + P2_QK + half * 36864); LAS bf16* kh = qh + 9216; LAS float* Tt = (LAS float*)(lds + P2_TT + half * 16384);
    LAS bf16* qkt = (LAS bf16*)(lds + P2_QKT + half * 9216);
    LAS float* sBeta = (LAS float*)(lds + P2_SC + half * 4096); LAS float* sG = sBeta + 64; LAS float* sP = sBeta + 128  ; LAS float* sR = sBeta + 384  ;
    const int wv = ht >> 6;
    stage_rows<5, 5>(pseq, t0 - 3, 67, PC_QKV + h0 * 128, lds, P2_STGP, tid);
    stage_rows<5, 5>(pseq, t0 - 3, 67, PC_QKV + 512 + h0 * 128, lds + 512, P2_STGP, tid);
    if (ht < 64) {
        const float bl = BA[(size_t)(row0 + ht) * 8 + h], al = BA[(size_t)(row0 + ht) * 8 + 4 + h];
        const float beta = sigmoidf_(bl);
        const float xg = al + a.in[I_DTB][l * 4 + h];
        const float sp = softplusf_(xg);
        float g = -__expf(a.in[I_ALOG][l * 4 + h]) * sp;
#pragma unroll
        for (int o = 1; o < 64; o <<= 1) { const float t = __shfl_up(g, o); if (lane >= o) g += t; }
        sBeta[ht] = beta; sG[ht] = g;
    }
    __syncthreads();
    const bool isq = ht < 128; const int ch = ht & 127;
    const float* cw = a.in[I_QKVW] + (size_t)l * 4 * 1536;
    float val[64];
    {
        const int wcol = (isq ? 0 : 512) + h * 128 + ch;
        const float w0 = cw[wcol], w1 = cw[1536 + wcol], w2 = cw[2 * 1536 + wcol], w3 = cw[3 * 1536 + wcol];
        const LAS bf16* sp = (const LAS bf16*)lds + (isq ? 0 : 256) + half * 128 + ch;
        float x0 = bf2f(sp[0]), x1 = bf2f(sp[528]), x2 = bf2f(sp[2 * 528]);
#pragma unroll
        for (int t = 0; t < 64; ++t) { const float x3 = bf2f(sp[(t + 3) * 528]); val[t] = siluf_((w0 * x0 + w1 * x1) + (w2 * x2 + w3 * x3)); x0 = x1; x1 = x2; x2 = x3; }
        float sq[64];
#pragma unroll
        for (int t = 0; t < 64; ++t) sq[t] = val[t] * val[t];
        const float tot = xreduce64(sq, lane);
        sP[wv * 64 + lane] = tot;
    }
    __syncthreads();
    if (ht < 128) { const int which = ht >> 6, t = ht & 63; const float ss = sP[(2 * which) * 64 + t] + sP[(2 * which + 1) * 64 + t]; sR[which * 64 + t] = rsqrtf(ss + EPS) * (which == 0 ? 0.08838834764831845f : 1.f); }
    stage_rows<5, 5>(pseq, t0 - 3, 67, PC_QKV + 1024 + h0 * 128, lds, P2_STGP, tid);
    __syncthreads();
    const float Glast = sG[63];
    {
        LAS bf16* dst = isq ? qh : kh;
        const LAS float* rr = sR + (isq ? 0 : 64);
#pragma unroll
        for (int t = 0; t < 64; ++t) { val[t] *= rr[t]; dst[t * 144 + ch] = f2bf(val[t]); }
        if (!isq) {
            u32x4* kt = (u32x4*)(pu + PU_KTT + ch * 128); const int ksw = (ch >> 1) & 7;
#pragma unroll
            for (int t8 = 0; t8 < 8; ++t8) { float e[8];
#pragma unroll
                for (int j = 0; j < 8; ++j) { const int tk = 32 * (t8 >> 2) + 16 * (j >> 2) + 4 * (t8 & 3) + (j & 3); e[j] = val[tk] * __expf(Glast - sG[tk]); }
                u32x4 o; o.x = cvtpk(e[0], e[1]); o.y = cvtpk(e[2], e[3]); o.z = cvtpk(e[4], e[5]); o.w = cvtpk(e[6], e[7]); kt[t8 ^ ksw] = o; }
#pragma unroll
            for (int t = 0; t < 64; ++t) val[t] *= sBeta[t] * __expf(sG[t]);
        }
    }
    if (isq) {
        const int wcol = 1024 + h * 128 + ch;
        const float w0 = cw[wcol], w1 = cw[1536 + wcol], w2 = cw[2 * 1536 + wcol], w3 = cw[3 * 1536 + wcol];
        const LAS bf16* sp = (const LAS bf16*)lds + half * 128 + ch;
        float x0 = bf2f(sp[0]), x1 = bf2f(sp[528]), x2 = bf2f(sp[2 * 528]);
#pragma unroll
        for (int t = 0; t < 64; ++t) { const float x3 = bf2f(sp[(t + 3) * 528]); val[t] = siluf_((w0 * x0 + w1 * x1) + (w2 * x2 + w3 * x3)) * sBeta[t]; x0 = x1; x1 = x2; x2 = x3; }
    }
    __syncthreads();
    LAS bf16* T16 = (LAS bf16*)(lds + half * 9216);
    LAS float* Dt = (LAS float*)(lds + 36864 + (tid >> 6) * 1024);
    LAS bf16* Dv = (LAS bf16*)(lds + 45056 + half * 2048);
    {
        const int q = lane >> 4, c = lane & 15, mi = wv;
        f32x4 kk[4], qk[4];
#pragma unroll
        for (int ni = 0; ni < 4; ++ni) { kk[ni] = (f32x4){0.f, 0.f, 0.f, 0.f}; qk[ni] = (f32x4){0.f, 0.f, 0.f, 0.f}; }
#pragma unroll
        for (int ks = 0; ks < 4; ++ks) {
            const bf16x8 ak = *(const LAS bf16x8*)(kh + (16 * mi + c) * 144 + ks * 32 + q * 8);
            const bf16x8 aq = *(const LAS bf16x8*)(qh + (16 * mi + c) * 144 + ks * 32 + q * 8);
#pragma unroll
            for (int ni = 0; ni < 4; ++ni) { const bf16x8 bk = *(const LAS bf16x8*)(kh + (16 * ni + c) * 144 + ks * 32 + q * 8); kk[ni] = MFMA16(ak, bk, kk[ni]); qk[ni] = MFMA16(aq, bk, qk[ni]); }
        }
#pragma unroll
        for (int ni = 0; ni < 4; ++ni) {
            float tn[4];
#pragma unroll
            for (int r = 0; r < 4; ++r) { const int i = 16 * mi + 4 * q + r, j = 16 * ni + c;
                const float dec = __expf(fminf(sG[i] - sG[j], 0.f));
                tn[r] = (i > j) ? -(sBeta[i] * kk[ni][r] * dec) : 0.f;
                T16[i * 72 + j] = f2bf(tn[r]);
                qkt[i * 72 + j] = f2bf((i >= j) ? qk[ni][r] * dec : 0.f); }
            if (ni == mi) {
#pragma unroll
                for (int r = 0; r < 4; ++r) Dt[(4 * q + r) * 16 + c] = tn[r];
            }
        }
        {
            float x[16];
#pragma unroll
            for (int r = 0; r < 16; ++r) { float s = (r == c) ? 1.f : 0.f;
#pragma unroll
                for (int s4 = 0; s4 < (r + 3) / 4; ++s4) { const f32x4 tr = *(const LAS f32x4*)(Dt + r * 16 + 4 * s4);
#pragma unroll
                    for (int e = 0; e < 4; ++e) if (4 * s4 + e < r) s += tr[e] * x[4 * s4 + e]; }
                x[r] = s; }
            if (lane < 16) {
#pragma unroll
                for (int r = 0; r < 16; ++r) Dv[(wv * 16 + r) * 16 + c] = f2bf(x[r]);
            }
        }
    }
#pragma unroll
    for (int i = 0; i < 4; ++i) { const int p = ht + 256 * i, t = p >> 4, L = p & 15, e0 = 32 * (L >> 2) + 4 * (L & 3);
        const u32x2 lo = *(const LAS u32x2*)(qh + t * 144 + e0), hi = *(const LAS u32x2*)(qh + t * 144 + e0 + 16);
        float f[8]; unpack8(lo, hi, f); const float eg = __expf(sG[t]);
        u32x4 o; o.x = cvtpk(f[0] * eg, f[1] * eg); o.y = cvtpk(f[2] * eg, f[3] * eg); o.z = cvtpk(f[4] * eg, f[5] * eg); o.w = cvtpk(f[6] * eg, f[7] * eg);
        *(u32x4*)(pu + PU_QG + t * 256 + ((L ^ (t & 15)) << 4)) = o; }
    __syncthreads();
    typedef short s16x4 __attribute__((ext_vector_type(4)));
    s16x4 Xb[4][4];
    {
        LAS bf16* rT = qh;
#pragma unroll
        for (int t8 = 0; t8 < 8; ++t8) { u32x4 o; o.x = cvtpk(val[8 * t8], val[8 * t8 + 1]); o.y = cvtpk(val[8 * t8 + 2], val[8 * t8 + 3]); o.z = cvtpk(val[8 * t8 + 4], val[8 * t8 + 5]); o.w = cvtpk(val[8 * t8 + 6], val[8 * t8 + 7]);
            *(LAS u32x4*)(rT + ht * 72 + 8 * t8) = o; }
        const int q = lane >> 4, c = lane & 15;
        f32x4* ub = (f32x4*)(pu + PU_UB);
#pragma unroll
        for (int I = 0; I < 4; ++I) {
            s16x4 ta[4];
#pragma unroll
            for (int J = 0; J < 4; ++J) if (J < I) ta[J] = *(const LAS s16x4*)(T16 + (16 * I + c) * 72 + 16 * J + 4 * q);
            const s16x4 da = *(const LAS s16x4*)(Dv + (I * 16 + c) * 16 + 4 * q);
#pragma unroll
            for (int k = 0; k < 4; ++k) {
                const u32x2 rv = *(const LAS u32x2*)(rT + (64 * wv + 16 * k + c) * 72 + 16 * I + 4 * q);
                f32x4 acc = (f32x4){__uint_as_float(rv.x << 16), __uint_as_float(rv.x & 0xffff0000u), __uint_as_float(rv.y << 16), __uint_as_float(rv.y & 0xffff0000u)};
#pragma unroll
                for (int J = 0; J < 4; ++J) if (J < I) acc = __builtin_amdgcn_mfma_f32_16x16x16bf16_1k(ta[J], Xb[J][k], acc, 0, 0, 0);
                u32x2 yb; yb.x = cvtpk(acc[0], acc[1]); yb.y = cvtpk(acc[2], acc[3]);
                const f32x4 x = __builtin_amdgcn_mfma_f32_16x16x16bf16_1k(da, __builtin_bit_cast(s16x4, yb), (f32x4){0.f, 0.f, 0.f, 0.f}, 0, 0, 0);
                u32x2 xb; xb.x = cvtpk(x[0], x[1]); xb.y = cvtpk(x[2], x[3]);
                Xb[I][k] = __builtin_bit_cast(s16x4, xb);
                if (isq) ub[((4 * wv + k) * 4 + I) * 64 + lane] = x;
            }
        }
    }
#pragma unroll
    for (int i = 0; i < 2; ++i) { const int p = ht + 256 * i, t = p >> 3, L = p & 7, e0 = 32 * (L >> 2) + 4 * (L & 3);
        const u32x2 lo = *(const LAS u32x2*)(qkt + t * 72 + e0), hi = *(const LAS u32x2*)(qkt + t * 72 + e0 + 16);
        u32x4 o; o.x = lo.x; o.y = lo.y; o.z = hi.x; o.w = hi.y; *(u32x4*)(pu + PU_QK + t * 128 + ((L ^ ((t >> 1) & 7)) << 4)) = o; }
    if (ht == 0) ((float*)(ws + WS_GLAST))[unit] = __expf(Glast);
    __syncthreads();
    LAS bf16* nt = (LAS bf16*)(lds + half * 17408);
    if (!isq) {
        const int q = lane >> 4, c = lane & 15;
#pragma unroll
        for (int I = 0; I < 4; ++I)
#pragma unroll
            for (int k = 0; k < 4; ++k)
#pragma unroll
                for (int r = 0; r < 4; ++r) *(LAS unsigned short*)(nt + (16 * I + 4 * q + r) * 136 + 64 * (wv - 2) + 16 * k + c) = (unsigned short)((unsigned short)Xb[I][k][r] ^ 0x8000u);
    }
    __syncthreads();
#pragma unroll
    for (int i = 0; i < 4; ++i) { const int p = ht + 256 * i, t = p >> 4, L = p & 15, e0 = 32 * (L >> 2) + 4 * (L & 3);
        const u32x2 lo = *(const LAS u32x2*)(nt + t * 136 + e0), hi = *(const LAS u32x2*)(nt + t * 136 + e0 + 16);
        u32x4 o; o.x = lo.x; o.y = lo.y; o.z = hi.x; o.w = hi.y; *(u32x4*)(pu + PU_NWC + t * 256 + ((L ^ (t & 15)) << 4)) = o; }
    __syncthreads();
}

constexpr int CP_G = 0, CP_AS = 96256, CP_OT = 0  ;
__device__ __forceinline__ void confpool_unit(const ArgsD& a, LAS unsigned char* lds, int l, int b, int n, int tid, int lane, int wave) {
    unsigned char* ws = a.ws;
    const bf16* pseq = (const bf16*)(ws + WS_PROJ) + (size_t)(b * SEQ) * NPROJ; bf16* MIX = (bf16*)(ws + WS_MIX);
    const int c = tid & 255, th = tid >> 8, t0 = 64 * n, row0 = b * SEQ + t0;
    LAS float* gl = (LAS float*)(lds + CP_G); LAS bf16* As = (LAS bf16*)(lds + CP_AS); LAS bf16* ot = (LAS bf16*)(lds + CP_OT);
    const int q = lane >> 4, cc = lane & 15;
    {
        u32x4 p1[6], p2[6];
#pragma unroll
        for (int i = 0; i < 6; ++i) { int it = tid + NTHR * i; it = it < 94 * 32 ? it : 94 * 32 - 1; const int r = it >> 5, o = it & 31; const int t = t0 - 30 + r, tc = t < 0 ? 0 : t;
            const bf16* pp = pseq + (size_t)tc * NPROJ + PC_GLU + 8 * o; p1[i] = *(const u32x4*)pp; p2[i] = *(const u32x4*)(pp + 256); }
#pragma unroll
        for (int i = 0; i < 6; ++i) { const int it = tid + NTHR * i; if (it < 94 * 32) { const int r = it >> 5, o = it & 31; const int t = t0 - 30 + r;
            float f1[8], f2[8]; unpack8((u32x2){p1[i].x, p1[i].y}, (u32x2){p1[i].z, p1[i].w}, f1); unpack8((u32x2){p2[i].x, p2[i].y}, (u32x2){p2[i].z, p2[i].w}, f2);
            f32x4 g0, g1;
#pragma unroll
            for (int e = 0; e < 4; ++e) { g0[e] = t >= 0 ? f1[e] * sigmoidf_(f2[e]) : 0.f; g1[e] = t >= 0 ? f1[4 + e] * sigmoidf_(f2[4 + e]) : 0.f; }
            *(LAS f32x4*)(gl + r * 256 + 8 * o) = g0; *(LAS f32x4*)(gl + r * 256 + 8 * o + 4) = g1; } }
    }
    __syncthreads();
    {
        float g[62];
#pragma unroll
        for (int i = 0; i < 62; ++i) g[i] = gl[(32 * th + i) * 256 + c];
        if (n == 31 && th == 1) { float* o = a.out + O_CP + ((size_t)(l * NBAT + b) * 30) * 256 + c;
#pragma unroll
            for (int r = 0; r < 30; ++r) o[r * 256] = g[32 + r]; }
        const float* dw = a.in[I_CDWW] + (size_t)l * 31 * 256 + c;
        float dc[32]; const float bias = a.in[I_CDWB][l * 256 + c];
        {
            typedef float f32x2s __attribute__((ext_vector_type(2)));
            f32x2s gE[31], gO[30], d2[16];
#pragma unroll
            for (int p = 0; p < 31; ++p) gE[p] = (f32x2s){g[2 * p], g[2 * p + 1]};
#pragma unroll
            for (int p = 0; p < 30; ++p) gO[p] = (f32x2s){g[2 * p + 1], g[2 * p + 2]};
#pragma unroll
            for (int p = 0; p < 16; ++p) d2[p] = (f32x2s){bias, bias};
#pragma unroll
            for (int j = 0; j < 31; ++j) { const float w = dw[j * 256]; const f32x2s w2 = (f32x2s){w, w};
#pragma unroll
                for (int p = 0; p < 16; ++p) d2[p] += w2 * ((j & 1) ? gO[p + (j - 1) / 2] : gE[p + j / 2]); }
#pragma unroll
            for (int p = 0; p < 16; ++p) { dc[2 * p] = d2[p][0]; dc[2 * p + 1] = d2[p][1]; }
        }
        float st[64];
#pragma unroll
        for (int i = 0; i < 32; ++i) { st[i] = dc[i]; st[32 + i] = dc[i] * dc[i]; }
        const float red = xreduce64(st, lane);
        const float lg = a.in[I_CLNG][l * 256 + c], lb = a.in[I_CLNB][l * 256 + c];
#pragma unroll
        for (int i = 0; i < 32; ++i) { const float mean = __shfl(red, i) * (1.f / 64.f); const float ex2 = __shfl(red, 32 + i) * (1.f / 64.f);
            const float var = fmaxf(ex2 - mean * mean, 0.f); const float dn = (dc[i] - mean) * rsqrtf(var + EPS) * lg + lb;
            As[(32 * th + i) * 272 + c] = f2bf(siluf_(dn)); }
    }
    __syncthreads();
    u32x4 pu_[5];
#pragma unroll
    for (int i = 0; i < 5; ++i) { int it = tid + NTHR * i; it = it < 79 * 32 ? it : 79 * 32 - 1; const int r = it >> 5, o = it & 31; const int t = t0 - 15 + r, tc = t < 0 ? 0 : t;
        pu_[i] = *(const u32x4*)(pseq + (size_t)tc * NPROJ + PC_POOL + 8 * o); if (t < 0) pu_[i] = (u32x4){0u, 0u, 0u, 0u}; }
    {
        const bf16* PWT = (const bf16*)(ws + WS_PWT) + (size_t)l * 65536;
        bf16x8 bfr[8][2];
#pragma unroll
        for (int ks = 0; ks < 8; ++ks)
#pragma unroll
            for (int j = 0; j < 2; ++j) bfr[ks][j] = *(const bf16x8*)(PWT + (size_t)((2 * wave + j) * 16 + cc) * 256 + ks * 32 + q * 8);
        f32x4 acc[4][2];
#pragma unroll
        for (int m = 0; m < 4; ++m) { acc[m][0] = (f32x4){0.f, 0.f, 0.f, 0.f}; acc[m][1] = (f32x4){0.f, 0.f, 0.f, 0.f}; }
#pragma unroll
        for (int ks = 0; ks < 8; ++ks)
#pragma unroll
            for (int m = 0; m < 4; ++m) { const bf16x8 af = *(const LAS bf16x8*)(As + (16 * m + cc) * 272 + ks * 32 + q * 8); acc[m][0] = MFMA16(af, bfr[ks][0], acc[m][0]); acc[m][1] = MFMA16(af, bfr[ks][1], acc[m][1]); }
#pragma unroll
        for (int m = 0; m < 4; ++m)
#pragma unroll
            for (int j = 0; j < 2; ++j)
#pragma unroll
                for (int r = 0; r < 4; ++r) ot[(16 * m + 4 * q + r) * 264 + (2 * wave + j) * 16 + cc] = f2bf(acc[m][j][r]);
    }
    LAS float* ul = (LAS float*)(lds + 33792);
    (void)ul;
    LAS bf16* ub16 = (LAS bf16*)(lds + 33792);
#pragma unroll
    for (int i = 0; i < 5; ++i) { const int it = tid + NTHR * i; if (it < 79 * 32) { const int r = it >> 5, o = it & 31; *(LAS u32x4*)(ub16 + r * 256 + 8 * o) = pu_[i]; } }
    __syncthreads();
    {
#pragma unroll
        for (int i = 0; i < 4; ++i) { const int p = tid + NTHR * i, t = p >> 5, o = p & 31; *(u32x4*)(MIX + (size_t)(row0 + t) * D + 768 + 8 * o) = *(const LAS u32x4*)(ot + t * 264 + 8 * o); }
        float cs[48]; float ucur[32]; float keep[15];
        float run = 0.f; cs[0] = 0.f;
#pragma unroll
        for (int i = 0; i < 47; ++i) { const float v = bf2f(ub16[(32 * th + i) * 256 + c]); run += v; cs[i + 1] = run; if (i >= 15) ucur[i - 15] = v; if (i >= 32) keep[i - 32] = v; }
        if (n == 31 && th == 1) { float* o = a.out + O_POOLP + ((size_t)(l * NBAT + b) * 15) * 256 + c;
#pragma unroll
            for (int r = 0; r < 15; ++r) o[r * 256] = keep[r]; }
        const int gi = c >> 6, tb = t0 + 32 * th;
#pragma unroll
        for (int i = 0; i < 32; ++i) {
            const float lo = gi == 0 ? cs[14 + i] : (gi == 1 ? cs[12 + i] : (gi == 2 ? cs[8 + i] : cs[i]));
            const float s = cs[16 + i] - lo; const int w = 2 << gi; const int tabs = tb + i; const float cnt = (float)(tabs + 1 < w ? tabs + 1 : w);
            As[(32 * th + i) * 272 + c] = f2bf(s * __builtin_amdgcn_rcpf(cnt) - ucur[i]); }
    }
    __syncthreads();
    {
        const bf16* PLT = (const bf16*)(ws + WS_POOLWT) + (size_t)l * 16384;
        f32x4 acc[4][2];
#pragma unroll
        for (int m = 0; m < 4; ++m) { acc[m][0] = (f32x4){0.f, 0.f, 0.f, 0.f}; acc[m][1] = (f32x4){0.f, 0.f, 0.f, 0.f}; }
        const int g = (2 * wave) >> 2;
        bf16x8 bfr[2][2];
#pragma unroll
        for (int ks = 0; ks < 2; ++ks)
#pragma unroll
            for (int j = 0; j < 2; ++j) { const int ct = 2 * wave + j, j0 = 16 * (ct & 3); bfr[ks][j] = *(const bf16x8*)(PLT + (size_t)g * 4096 + (j0 + cc) * 64 + ks * 32 + q * 8); }
#pragma unroll
        for (int ks = 0; ks < 2; ++ks)
#pragma unroll
            for (int m = 0; m < 4; ++m) { const bf16x8 af = *(const LAS bf16x8*)(As + (16 * m + cc) * 272 + g * 64 + ks * 32 + q * 8); acc[m][0] = MFMA16(af, bfr[ks][0], acc[m][0]); acc[m][1] = MFMA16(af, bfr[ks][1], acc[m][1]); }
#pragma unroll
        for (int j = 0; j < 2; ++j) { const int col = (2 * wave + j) * 16 + cc; const float sc = a.in[I_POOLSC][l * 256 + col];
#pragma unroll
            for (int m = 0; m < 4; ++m)
#pragma unroll
                for (int r = 0; r < 4; ++r) ot[(16 * m + 4 * q + r) * 264 + col] = f2bf(acc[m][j][r] * sc); }
    }
    __syncthreads();
#pragma unroll
    for (int i = 0; i < 4; ++i) { const int p = tid + NTHR * i, t = p >> 5, o = p & 31; *(u32x4*)(MIX + (size_t)(row0 + t) * D + 8 * o) = *(const LAS u32x4*)(ot + t * 264 + 8 * o); }
    if (n == 31) {
        for (int i = tid; i < 3 * 1536; i += NTHR) { const int r = i / 1536, col = i % 1536; a.out[O_QCP + ((size_t)(l * NBAT + b) * 3 + r) * 1536 + col] = bf2f(pseq[(size_t)(SEQ - 3 + r) * NPROJ + PC_QKV + col]); }
    }
    __syncthreads();
}

constexpr int SL_NWC = 0, SL_QG = 16384, SL_QK = 32768, SL_KT = 40960, SL_BUF = 57344, SL_O = 2 * SL_BUF, SL_OP = 272, SL_OBUF = 64 * SL_OP, SL_END = SL_O + 2 * SL_OBUF;
__device__ __forceinline__ void scan_dma(const unsigned char* pu, LAS unsigned char* buf, int wave, int lane) {
#pragma unroll
    for (int i = 0; i < 7; ++i) { const int p = wave + 8 * i; __builtin_amdgcn_global_load_lds((const unsigned*)(pu + p * 1024 + lane * 16), (LAS unsigned*)(buf + p * 1024), 16, 0, 0); }
}
__device__ __forceinline__ void scan_finalise(const LAS unsigned char* obuf, const u32x4 z0, const u32x4 z1, const f32x4 (&gn)[4], bf16* mo, int ft, int fc) {
            const u32x4 o0 = *(const LAS u32x4*)(obuf + ft * SL_OP + fc * 2), o1 = *(const LAS u32x4*)(obuf + ft * SL_OP + fc * 2 + 16);
            float ov[16], zv[16];
#pragma unroll
            for (int j = 0; j < 4; ++j) { ov[2 * j] = __uint_as_float(o0[j] << 16); ov[2 * j + 1] = __uint_as_float(o0[j] & 0xffff0000u); ov[8 + 2 * j] = __uint_as_float(o1[j] << 16); ov[8 + 2 * j + 1] = __uint_as_float(o1[j] & 0xffff0000u);
                zv[2 * j] = __uint_as_float(z0[j] << 16); zv[2 * j + 1] = __uint_as_float(z0[j] & 0xffff0000u); zv[8 + 2 * j] = __uint_as_float(z1[j] << 16); zv[8 + 2 * j + 1] = __uint_as_float(z1[j] & 0xffff0000u); }
            float ss = 0.f;
#pragma unroll
            for (int j = 0; j < 16; ++j) ss += ov[j] * ov[j];
            ss = dpp_add<0xB1>(ss); ss = dpp_add<0x4E>(ss); ss = dpp_add<0x141>(ss);
            const float rn = rsqrtf(ss * (1.f / 128.f) + EPS);
            float res[16];
#pragma unroll
            for (int j = 0; j < 16; ++j) res[j] = ov[j] * rn * gn[j >> 2][j & 3] * siluf_(zv[j]);
            u32x4 w0, w1;
#pragma unroll
            for (int j = 0; j < 4; ++j) { w0[j] = cvtpk(res[2 * j], res[2 * j + 1]); w1[j] = cvtpk(res[8 + 2 * j], res[8 + 2 * j + 1]); }
            *(u32x4*)mo = w0; *(u32x4*)(mo + 8) = w1;
}
__device__ __forceinline__ void scan_unit(const ArgsD& a, LAS unsigned char* lds, int l, int b, int h, int tid, int lane, int wave) {
    unsigned char* ws = a.ws;
    const bf16* PROJ = (const bf16*)(ws + WS_PROJ); bf16* MIX = (bf16*)(ws + WS_MIX); const float* GL = (const float*)(ws + WS_GLAST);
    const int q = lane >> 4, c = lane & 15, w = wave;
    f32x4 S[8];
#pragma unroll
    for (int m = 0; m < 8; ++m) S[m] = (f32x4){0.f, 0.f, 0.f, 0.f};
    const int ft = 8 * w + (lane >> 3), fc = 16 * (lane & 7);
    f32x4 gn[4];
#pragma unroll
    for (int j = 0; j < 4; ++j) gn[j] = *(const f32x4*)(a.in[I_DNG] + l * 128 + fc + 4 * j);
    f32x4 uaN[4]; float glN;
    {
        const int unit0 = (b * 32) * 4 + h; const unsigned char* pu0 = ws + WS_PREP + (size_t)unit0 * PREP_UNIT;
        scan_dma(pu0, lds, wave, lane);
#pragma unroll
        for (int m = 0; m < 4; ++m) uaN[m] = *(const f32x4*)(pu0 + PU_UB + ((w * 4 + m) * 64 + lane) * 16);
        glN = GL[unit0];
    }
    asm volatile("s_waitcnt vmcnt(0)" ::: "memory"); __builtin_amdgcn_s_barrier(); asm volatile("" ::: "memory");
    int offA[4], offB[2];
#pragma unroll
    for (int ks = 0; ks < 4; ++ks) offA[ks] = c * 256 + (((4 * ks + q) ^ c) << 4);
#pragma unroll
    for (int ks = 0; ks < 2; ++ks) offB[ks] = c * 128 + (((4 * ks + q) ^ (c >> 1)) << 4);
    u32x4 zp0 = (u32x4){0u, 0u, 0u, 0u}, zp1 = zp0;
    for (int n = 0; n < 32; ++n) {
        const int unit = (b * 32 + n) * 4 + h;
        const unsigned char* pu = ws + WS_PREP + (size_t)unit * PREP_UNIT;
        LAS unsigned char* buf = lds + (n & 1) * SL_BUF;
        LAS unsigned char* obuf = lds + SL_O + (n & 1) * SL_OBUF;
        f32x4 ua[4], oa[4];
#pragma unroll
        for (int m = 0; m < 4; ++m) { ua[m] = uaN[m]; oa[m] = (f32x4){0.f, 0.f, 0.f, 0.f}; }
        const float gl = glN;
        const size_t rowf = (size_t)(b * SEQ + n * 64 + ft);
        if (n + 1 < 32) {
            scan_dma(pu + (size_t)4 * PREP_UNIT, lds + ((n + 1) & 1) * SL_BUF, wave, lane);
#pragma unroll
            for (int m = 0; m < 4; ++m) uaN[m] = *(const f32x4*)(pu + (size_t)4 * PREP_UNIT + PU_UB + ((w * 4 + m) * 64 + lane) * 16);
            glN = GL[unit + 4];
        }
        const u32x4 z0_ = *(const u32x4*)(PROJ + rowf * NPROJ + PC_Z + h * 128 + fc), z1_ = *(const u32x4*)(PROJ + rowf * NPROJ + PC_Z + h * 128 + fc + 8);
        if (n > 0) scan_finalise(lds + SL_O + ((n - 1) & 1) * SL_OBUF, zp0, zp1, gn, MIX + (rowf - 64) * D + 256 + h * 128 + fc, ft, fc);
        bf16x8 Sb[4];
#pragma unroll
        for (int ks = 0; ks < 4; ++ks) Sb[ks] = pack8(S[2 * ks], S[2 * ks + 1]);
        bf16x8 fa[8], fb[8];
#define SCHED_ __builtin_amdgcn_sched_barrier(0)
#define LD_A(dst, ks) do { _Pragma("unroll") for (int m = 0; m < 4; ++m) { dst[m] = *(const LAS bf16x8*)(buf + SL_QG + m * 4096 + offA[ks]); dst[4 + m] = *(const LAS bf16x8*)(buf + SL_NWC + m * 4096 + offA[ks]); } } while (0)
#define MM_A(src, ks) do { _Pragma("unroll") for (int m = 0; m < 4; ++m) { oa[m] = MFMA16(src[m], Sb[ks], oa[m]); ua[m] = MFMA16(src[4 + m], Sb[ks], ua[m]); } } while (0)
#define LD_KT(dst, ks) do { _Pragma("unroll") for (int m = 0; m < 8; ++m) dst[m] = *(const LAS bf16x8*)(buf + SL_KT + m * 2048 + offB[ks]); } while (0)
#define MM_KT(src, ks) do { _Pragma("unroll") for (int m = 0; m < 8; ++m) S[m] = MFMA16(src[m], Ub[ks], S[m]); } while (0)
        LD_A(fa, 0); SCHED_;
        LD_A(fb, 1); SCHED_; MM_A(fa, 0); SCHED_;
        LD_A(fa, 2); SCHED_; MM_A(fb, 1); SCHED_;
        LD_A(fb, 3); SCHED_; MM_A(fa, 2); SCHED_;
#pragma unroll
        for (int ks = 0; ks < 2; ++ks)
#pragma unroll
            for (int m = 0; m < 4; ++m) fa[ks * 4 + m] = *(const LAS bf16x8*)(buf + SL_QK + m * 2048 + offB[ks]);
        SCHED_; MM_A(fb, 3); SCHED_;
        bf16x8 Ub[2];
        Ub[0] = pack8(ua[0], ua[1]); Ub[1] = pack8(ua[2], ua[3]);
        LD_KT(fb, 0); SCHED_;
#pragma unroll
        for (int ks = 0; ks < 2; ++ks)
#pragma unroll
            for (int m = 0; m < 4; ++m) oa[m] = MFMA16(fa[ks * 4 + m], Ub[ks], oa[m]);
#pragma unroll
        for (int m = 0; m < 8; ++m) S[m] = S[m] * gl;
        SCHED_;
        LD_KT(fa, 1); SCHED_; MM_KT(fb, 0); SCHED_;
        MM_KT(fa, 1); SCHED_;
#undef LD_A
#undef MM_A
#undef LD_KT
#undef MM_KT
#pragma unroll
        for (int m = 0; m < 4; ++m)
#pragma unroll
            for (int r = 0; r < 4; ++r) *(LAS bf16*)(obuf + (16 * m + 4 * q + r) * SL_OP + (16 * w + c) * 2) = f2bf(oa[m][r]);
        asm volatile("s_waitcnt vmcnt(0) lgkmcnt(0)" ::: "memory"); __builtin_amdgcn_s_barrier(); asm volatile("" ::: "memory");
        zp0 = z0_; zp1 = z1_; asm volatile("" : "+v"(zp0), "+v"(zp1));
    }
    scan_finalise(lds + SL_O + SL_OBUF, zp0, zp1, gn, MIX + (size_t)(b * SEQ + 31 * 64 + ft) * D + 256 + h * 128 + fc, ft, fc);
    float* so = a.out + O_DP + ((size_t)((l * NBAT + b) * 4 + h)) * 128 * 128;
#pragma unroll
    for (int m = 0; m < 8; ++m)
#pragma unroll
        for (int r = 0; r < 4; ++r) so[(16 * m + 4 * q + r) * 128 + 16 * w + c] = S[m][r];
    asm volatile("s_waitcnt vmcnt(0) lgkmcnt(0)" ::: "memory");
    __syncthreads();
}

__device__ __forceinline__ void sample_ac_unit(const ArgsD& a, LAS unsigned char* lds, int l, int sb, int which, int tid, int lane) {
    unsigned char* ws = a.ws;
    const int row = MP + sb; const bf16* pr = (const bf16*)(ws + WS_PROJ) + (size_t)row * NPROJ; bf16* mix = (bf16*)(ws + WS_MIX) + (size_t)row * D;
    LAS float* dv = (LAS float*)lds;
    const int half = tid >> 8, c = tid & 255;
    if (which == 0) {
        if (half == 0) {
            const float* st = a.in[I_SPOOL] + ((size_t)(l * NS + sb) * 15) * 256 + c; float* o = a.out + O_POOLS + ((size_t)(l * NS + sb) * 15) * 256 + c;
            const float u = bf2f(pr[PC_POOL + c]); const int w = 2 << (c >> 6);
            float v[15];
#pragma unroll
            for (int r = 0; r < 15; ++r) v[r] = st[r * 256];
            float s = u;
#pragma unroll
            for (int r = 0; r < 15; ++r) { if (r >= 16 - w) s += v[r]; if (r >= 1) o[(r - 1) * 256] = v[r]; }
            o[14 * 256] = u;
            dv[c] = s * __builtin_amdgcn_rcpf((float)w) - u;
        }
        __syncthreads();
        {
            const int g = c >> 6, j = c & 63; const float* pw = a.in[I_POOLW] + (size_t)(l * 4 + g) * 4096 + (size_t)(32 * half) * 64 + j; float acc = 0.f;
#pragma unroll
            for (int i = 0; i < 32; ++i) acc += dv[g * 64 + 32 * half + i] * pw[i * 64];
            dv[256 + tid] = acc;
        }
        __syncthreads();
        if (half == 0) mix[c] = f2bf((dv[256 + c] + dv[512 + c]) * a.in[I_POOLSC][l * 256 + c]);
    } else {
        if (half == 0) {
            const float* st = a.in[I_SCONV] + ((size_t)(l * NS + sb) * 30) * 256 + c; float* o = a.out + O_CS + ((size_t)(l * NS + sb) * 30) * 256 + c;
            const float glu = bf2f(pr[PC_GLU + c]) * sigmoidf_(bf2f(pr[PC_GLU + 256 + c]));
            const float* dw = a.in[I_CDWW] + (size_t)l * 31 * 256 + c;
            float v[30], wv[31];
#pragma unroll
            for (int r = 0; r < 30; ++r) { v[r] = st[r * 256]; wv[r] = dw[r * 256]; }
            wv[30] = dw[30 * 256];
            float dc = a.in[I_CDWB][l * 256 + c] + wv[30] * glu;
#pragma unroll
            for (int r = 0; r < 30; ++r) { dc += wv[r] * v[r]; if (r >= 1) o[(r - 1) * 256] = v[r]; }
            o[29 * 256] = glu;
            const float mean = wave_sum(dc) * (1.f / 64.f); const float df = dc - mean; const float var = wave_sum(df * df) * (1.f / 64.f);
            const float dn = df * rsqrtf(var + EPS) * a.in[I_CLNG][l * 256 + c] + a.in[I_CLNB][l * 256 + c];
            dv[c] = siluf_(dn);
        }
        __syncthreads();
        {
            const float* pw = a.in[I_CPW] + (size_t)l * 65536 + (size_t)(128 * half) * 256 + c; float acc = 0.f;
#pragma unroll 16
            for (int i = 0; i < 128; ++i) acc += dv[128 * half + i] * pw[i * 256];
            dv[256 + tid] = acc;
        }
        __syncthreads();
        if (half == 0) mix[768 + c] = f2bf(dv[256 + c] + dv[512 + c]);
    }
    __syncthreads();
}
__device__ __forceinline__ void sample_delta_unit(const ArgsD& a, LAS unsigned char* lds, int l, int sb, int h, int tid, int lane, int wave) {
    unsigned char* ws = a.ws;
    const int row = MP + sb; const bf16* pr = (const bf16*)(ws + WS_PROJ) + (size_t)row * NPROJ; bf16* mix = (bf16*)(ws + WS_MIX) + (size_t)row * D;
    const float* BA = (const float*)(ws + WS_BA) + (size_t)row * 8;
    LAS float* sq = (LAS float*)lds;
    LAS float* scal = sq + 384; LAS float* part = sq + 400; LAS float* osq = sq + 1424;
    if (tid < 384) {
        const int s = tid >> 7, c = tid & 127, wcol = s * 512 + h * 128 + c;
        const float* st = a.in[I_SQKV] + ((size_t)(l * NS + sb) * 3) * 1536 + wcol; float* o = a.out + O_QCS + ((size_t)(l * NS + sb) * 3) * 1536 + wcol;
        const float* cw = a.in[I_QKVW] + (size_t)l * 4 * 1536 + wcol;
        const float x0 = st[0], x1 = st[1536], x2 = st[2 * 1536], x3 = bf2f(pr[PC_QKV + wcol]);
        o[0] = x1; o[1536] = x2; o[2 * 1536] = x3;
        sq[tid] = siluf_((cw[0] * x0 + cw[1536] * x1) + (cw[2 * 1536] * x2 + cw[3 * 1536] * x3));
    }
    __syncthreads();
    if (wave == 0) {
        const float q0 = sq[lane], q1 = sq[64 + lane], k0 = sq[128 + lane], k1 = sq[192 + lane];
        const float ssq = wave_sum(q0 * q0 + q1 * q1), ssk = wave_sum(k0 * k0 + k1 * k1), qk = wave_sum(q0 * k0 + q1 * k1);
        if (lane == 0) { const float rq = rsqrtf(ssq + EPS) * 0.08838834764831845f, rk = rsqrtf(ssk + EPS);
            const float beta = sigmoidf_(BA[h]); const float xg = BA[4 + h] + a.in[I_DTB][l * 4 + h]; const float sp = softplusf_(xg);
            const float g = -__expf(a.in[I_ALOG][l * 4 + h]) * sp;
            scal[0] = rq; scal[1] = rk; scal[2] = qk * rq * rk; scal[3] = beta; scal[4] = __expf(g); }
    }
    __syncthreads();
    const float rq = scal[0], rk = scal[1], qkd = scal[2], beta = scal[3], eg = scal[4];
    const int dq = tid >> 7, dvi = tid & 127;
    const float* Sin = a.in[I_SDELTA] + ((size_t)((l * NS + sb) * 4 + h)) * 16384 + (size_t)(32 * dq) * 128 + dvi;
    float s[32]; float ks = 0.f, qs = 0.f;
#pragma unroll
    for (int i = 0; i < 32; ++i) s[i] = Sin[i * 128];
#pragma unroll
    for (int i = 0; i < 32; ++i) { ks += sq[128 + 32 * dq + i] * s[i]; qs += sq[32 * dq + i] * s[i]; }
    part[dq * 128 + dvi] = ks * rk; part[512 + dq * 128 + dvi] = qs * rq;
    __syncthreads();
    const float kS = (part[dvi] + part[128 + dvi]) + (part[256 + dvi] + part[384 + dvi]);
    const float qS = (part[512 + dvi] + part[640 + dvi]) + (part[768 + dvi] + part[896 + dvi]);
    const float u = beta * (sq[256 + dvi] - eg * kS);
    const float o = eg * qS + qkd * u;
    float* So = a.out + O_DS + ((size_t)((l * NS + sb) * 4 + h)) * 16384 + (size_t)(32 * dq) * 128 + dvi;
#pragma unroll
    for (int i = 0; i < 32; ++i) So[i * 128] = eg * s[i] + (sq[128 + 32 * dq + i] * rk) * u;
    if (dq == 0) { const float t = wave_sum(o * o); if (lane == 0) osq[wave] = t; }
    __syncthreads();
    if (dq == 0) { const float ss = osq[0] + osq[1]; const float z = bf2f(pr[PC_Z + h * 128 + dvi]);
        mix[256 + h * 128 + dvi] = f2bf(o * rsqrtf(ss * (1.f / 128.f) + EPS) * a.in[I_DNG][l * 128 + dvi] * siluf_(z)); }
    __syncthreads();
}


struct EpiSBf16 { bf16* O; int ldc; int act;
    __device__ __forceinline__ void operator()(const f32x4& v, int row0, int col) const {
#pragma unroll
        for (int r = 0; r < 4; ++r) { float x = v[r]; if (act == 2) { x = fmaxf(x, 0.f); x = x * x; } O[(size_t)(row0 + r) * ldc + col] = f2bf(x); } } };
struct EpiSResid { float* X; const float* gate;
    __device__ __forceinline__ void operator()(const f32x4& v, int row0, int col) const {
#pragma unroll
        for (int r = 0; r < 4; ++r) { const int row = row0 + r; float* xp = X + (size_t)row * D + col; *xp = *xp + gate[(size_t)(NBAT + row) * MODW + col] * v[r]; } } };
template <int KS, int K, class Epi>
__device__ __forceinline__ void skinny_unit(const bf16* A, int lda, const bf16* Bt, int ct, int rg, const Epi& E, LAS unsigned char* lds, int tid, int lane, int wave) {
    constexpr int RT = 8 / KS, NB = K / 256, KLEN = K / KS, NF = KLEN / 32;
    static_assert(NF == 32, "skinny_unit: K / KS must be 1024");
    const int rtl = wave % RT, kp = wave / RT, rt = rg * RT + rtl;
    const int q = lane >> 4, c = lane & 15;
    u32x4 bst[NB];
#pragma unroll
    for (int i = 0; i < NB; ++i) { const int p = tid + NTHR * i, col = p / (K / 8), chunk = p % (K / 8); bst[i] = *(const u32x4*)(Bt + (size_t)(ct * 16 + col) * K + chunk * 8); }
    const bf16* ap = A + (size_t)(rt * 16 + c) * lda + kp * KLEN + q * 8;
    bf16x8 a0[16], a1[16];
#pragma unroll
    for (int j = 0; j < 16; ++j) a0[j] = *(const bf16x8*)(ap + j * 32);
#pragma unroll
    for (int i = 0; i < NB; ++i) { const int p = tid + NTHR * i, col = p / (K / 8), chunk = p % (K / 8); *(LAS u32x4*)(lds + (chunk * 16 + col) * 16) = bst[i]; }
#pragma unroll
    for (int j = 0; j < 16; ++j) a1[j] = *(const bf16x8*)(ap + (16 + j) * 32);
    __syncthreads();
    f32x4 acc0 = (f32x4){0.f, 0.f, 0.f, 0.f}, acc1 = (f32x4){0.f, 0.f, 0.f, 0.f};
    const LAS unsigned char* bl = lds + ((kp * (KLEN / 8) + q) * 16 + c) * 16;
#pragma unroll
    for (int j = 0; j < 16; j += 2) { acc0 = MFMA16(a0[j], *(const LAS bf16x8*)(bl + j * 1024), acc0); acc1 = MFMA16(a0[j + 1], *(const LAS bf16x8*)(bl + (j + 1) * 1024), acc1); }
#pragma unroll
    for (int j = 0; j < 16; j += 2) { acc0 = MFMA16(a1[j], *(const LAS bf16x8*)(bl + (16 + j) * 1024), acc0); acc1 = MFMA16(a1[j + 1], *(const LAS bf16x8*)(bl + (17 + j) * 1024), acc1); }
    f32x4 acc = acc0 + acc1;
    if (KS > 1) {
        LAS float* red = (LAS float*)(lds + 131072);
        *(LAS f32x4*)(red + (wave * 64 + lane) * 4) = acc;
        __syncthreads();
        if (kp == 0) {
#pragma unroll
            for (int p = 1; p < KS; ++p) acc = acc + *(const LAS f32x4*)(red + ((p * RT + rtl) * 64 + lane) * 4);
            E(acc, rt * 16 + 4 * q, ct * 16 + c);
        }
    } else {
        E(acc, rt * 16 + 4 * q, ct * 16 + c);
    }
    __syncthreads();
}
__device__ __forceinline__ void sub_barrier(unsigned* cnt, unsigned nwg) {
    asm volatile("s_waitcnt vmcnt(0) lgkmcnt(0)" ::: "memory");
    __syncthreads();
    if (threadIdx.x == 0) {
        __builtin_amdgcn_fence(__ATOMIC_RELEASE, "agent");
        asm volatile("s_waitcnt vmcnt(0)" ::: "memory");
        __hip_atomic_fetch_add(cnt, 1u, __ATOMIC_RELAXED, __HIP_MEMORY_SCOPE_AGENT);
        unsigned spins = 0;
        while (__hip_atomic_load(cnt, __ATOMIC_RELAXED, __HIP_MEMORY_SCOPE_AGENT) < nwg) { __builtin_amdgcn_s_sleep(1); if (++spins > (1u << 22)) break; }
        __builtin_amdgcn_fence(__ATOMIC_ACQUIRE, "agent");
        asm volatile("s_waitcnt vmcnt(0)" ::: "memory");
    }
    __syncthreads();
}
__device__ __forceinline__ void norm_row(const float* xr, const float* gvec, const float* mp, bf16* orow, int lane) {
    f32x4 v[4]; float s = 0.f;
#pragma unroll
    for (int j = 0; j < 4; ++j) { v[j] = *(const f32x4*)(xr + 4 * lane + 256 * j); s += (v[j][0] * v[j][0] + v[j][1] * v[j][1]) + (v[j][2] * v[j][2] + v[j][3] * v[j][3]); }
    const float rinv = rsqrtf(wave_sum(s) * (1.f / D) + EPS);
    u32x2* o8 = (u32x2*)orow + lane;
#pragma unroll
    for (int j = 0; j < 4; ++j) { const f32x4 g4 = *(const f32x4*)(gvec + 4 * lane + 256 * j), sh = *(const f32x4*)(mp + 4 * lane + 256 * j), sc = *(const f32x4*)(mp + D + 4 * lane + 256 * j);
        const f32x4 h = v[j] * rinv * g4 * (sc + 1.f) + sh; o8[64 * j] = (u32x2){cvtpk(h[0], h[1]), cvtpk(h[2], h[3])}; }
}
#ifndef MK_PER_PHASE
#define MK_PER_PHASE 0
#endif

#ifdef NO_PREP
#define KNOB_PREP(x)
#else
#define KNOB_PREP(x) x
#endif
#ifdef NO_CONF
#define KNOB_CONF(x)
#else
#define KNOB_CONF(x) x
#endif
#ifdef NO_SCAN
#define KNOB_SCAN(x)
#else
#define KNOB_SCAN(x) x
#endif
#ifdef NO_SAC
#define KNOB_SAC(x)
#else
#define KNOB_SAC(x) x
#endif
#ifdef NO_SD
#define KNOB_SD(x)
#else
#define KNOB_SD(x) x
#endif

#define RLX_AGENT __ATOMIC_RELAXED, __HIP_MEMORY_SCOPE_AGENT
#define XB_TMO      128
#define XB_XCNT(j)  (256  + 64 * (j))
#define XB_XSUB(j)  (1280 + 64 * (j))
#define XB_XGEN(j)  (2304 + 64 * (j))
#define XB_TOP      3328
#define XB_TOPGEN   3392
#define XCD_BAR_WORDS 3456
#define XB_SPIN_CAP (1u << 18)

__device__ __forceinline__ unsigned xb_ld(unsigned* p)              { return __hip_atomic_load(p, __ATOMIC_RELAXED, __HIP_MEMORY_SCOPE_AGENT); }
__device__ __forceinline__ unsigned xb_add(unsigned* p, unsigned v) { return __hip_atomic_fetch_add(p, v, __ATOMIC_RELAXED, __HIP_MEMORY_SCOPE_AGENT); }
__device__ __forceinline__ unsigned xb_xcc_id() { return (unsigned)__builtin_amdgcn_s_getreg((3 << 11) | 20) & 0xFu; }
#define XB_SPIN(cond, bar) do { unsigned _sp = 0; while (cond) { __builtin_amdgcn_s_sleep(1); \
    if ((++_sp & 255u) == 0u) { if (xb_ld(&(bar)[XB_TMO])) break; if (_sp > XB_SPIN_CAP) { atomicAdd(&(bar)[XB_TMO], 1u); break; } } } } while (0)

struct XcdBarrier {
    unsigned* bar; unsigned x;
    volatile LAS unsigned* st;
};

__device__ __forceinline__ XcdBarrier xcd_barrier_post(unsigned* bar, volatile LAS unsigned* st) {
    XcdBarrier b; b.bar = bar; b.x = xb_xcc_id(); b.st = st;
    if (threadIdx.x == 0) (void)xb_add(&bar[XB_XCNT(b.x)], 1u);
    return b;
}
__device__ __forceinline__ void xcd_barrier_complete(unsigned* bar, unsigned x, unsigned& nloc, unsigned& nx) {
    const unsigned G = gridDim.x * gridDim.y * gridDim.z;
    unsigned sum, cnt, mine, sp = 0u;
    for (;;) {
        sum = 0u; cnt = 0u; mine = 0u;
#pragma unroll
        for (unsigned j = 0; j < 16; ++j) { const unsigned c = xb_ld(&bar[XB_XCNT(j)]); sum += c; cnt += (c > 0u) ? 1u : 0u; mine = (j == x) ? c : mine; }
        if (sum == G) break;
        __builtin_amdgcn_s_sleep(1);
        if ((++sp & 255u) == 0u) { if (xb_ld(&bar[XB_TMO])) break; if (sp > XB_SPIN_CAP) { atomicAdd(&bar[XB_TMO], 1u); break; } }
    }
    nloc = mine > 0u ? mine : 1u; nx = cnt > 0u ? cnt : 1u;
}

__device__ __forceinline__ void xcd_barrier(const XcdBarrier& b) {
    asm volatile("s_waitcnt vmcnt(0)" ::: "memory");
    __syncthreads();
    if (threadIdx.x == 0) {
        unsigned* bar = b.bar;
        __builtin_amdgcn_s_waitcnt(0);
        unsigned nloc = b.st[0], nx = b.st[1];
        if (nloc == 0u) { xcd_barrier_complete(bar, b.x, nloc, nx); b.st[0] = nloc; b.st[1] = nx; }
        const unsigned old = xb_add(&bar[XB_XSUB(b.x)], 1u);
        const unsigned gen = old / nloc;
        if (old + 1u == (gen + 1u) * nloc) {
            __builtin_amdgcn_fence(__ATOMIC_RELEASE, "agent");
            asm volatile("s_waitcnt vmcnt(0)" ::: "memory");
            const unsigned og = xb_add(&bar[XB_TOP], 1u);
            const unsigned tg = og / nx;
            if (og + 1u == (tg + 1u) * nx) xb_add(&bar[XB_TOPGEN], 1u);
            else XB_SPIN(xb_ld(&bar[XB_TOPGEN]) == tg, bar);
            __builtin_amdgcn_fence(__ATOMIC_ACQUIRE, "agent");
            xb_add(&bar[XB_XGEN(b.x)], 1u);
            asm volatile("s_waitcnt vmcnt(0)" ::: "memory");
        } else {
            XB_SPIN(xb_ld(&bar[XB_XGEN(b.x)]) == gen, bar);
            __builtin_amdgcn_fence(__ATOMIC_ACQUIRE, "agent");
            asm volatile("s_waitcnt vmcnt(0)" ::: "memory");
        }
    }
    __syncthreads();
}

__device__ __attribute__((noinline)) void xcd_barrier_subset(unsigned* bar, volatile LAS unsigned* st, unsigned total) {
    asm volatile("s_waitcnt vmcnt(0)" ::: "memory");
    __syncthreads();
    if (threadIdx.x == 0) {
        __builtin_amdgcn_s_waitcnt(0);
        const unsigned x = xb_xcc_id();
        unsigned nloc = st[0], nx = st[1];
        if (nloc == 0u) {
            unsigned sum, cnt, mine, sp = 0u;
            for (;;) {
                sum = 0u; cnt = 0u; mine = 0u;
#pragma unroll
                for (unsigned j = 0; j < 16; ++j) { const unsigned c = xb_ld(&bar[XB_XCNT(j)]); sum += c; cnt += (c > 0u) ? 1u : 0u; mine = (j == x) ? c : mine; }
                if (sum == total) break;
                __builtin_amdgcn_s_sleep(1);
                if ((++sp & 255u) == 0u) { if (xb_ld(&bar[XB_TMO])) break; if (sp > XB_SPIN_CAP) { atomicAdd(&bar[XB_TMO], 1u); break; } }
            }
            nloc = mine > 0u ? mine : 1u; nx = cnt > 0u ? cnt : 1u; st[0] = nloc; st[1] = nx;
        }
        const unsigned old = xb_add(&bar[XB_XSUB(x)], 1u);
        const unsigned gen = old / nloc;
        if (old + 1u == (gen + 1u) * nloc) {
            __builtin_amdgcn_fence(__ATOMIC_RELEASE, "agent");
            asm volatile("s_waitcnt vmcnt(0)" ::: "memory");
            const unsigned og = xb_add(&bar[XB_TOP], 1u);
            const unsigned tg = og / nx;
            if (og + 1u == (tg + 1u) * nx) xb_add(&bar[XB_TOPGEN], 1u);
            else XB_SPIN(xb_ld(&bar[XB_TOPGEN]) == tg, bar);
            __builtin_amdgcn_fence(__ATOMIC_ACQUIRE, "agent");
            xb_add(&bar[XB_XGEN(x)], 1u);
            asm volatile("s_waitcnt vmcnt(0)" ::: "memory");
        } else {
            XB_SPIN(xb_ld(&bar[XB_XGEN(x)]) == gen, bar);
            __builtin_amdgcn_fence(__ATOMIC_ACQUIRE, "agent");
            asm volatile("s_waitcnt vmcnt(0)" ::: "memory");
        }
    }
    __syncthreads();
}
__device__ __forceinline__ void gsync_(cg::grid_group& grid) { asm volatile("s_waitcnt vmcnt(0) lgkmcnt(0)" ::: "memory"); grid.sync(); }
constexpr int N_PHASES = 34;
__global__ void __launch_bounds__(NTHR, 2) __attribute__((amdgpu_waves_per_eu(2, 2))) hybrid_fwd(Args args_k) {
    extern __shared__ __attribute__((aligned(16))) unsigned char lds_raw[];
    LAS unsigned char* lds = (LAS unsigned char*)lds_raw;
    cg::grid_group grid = cg::this_grid();
    if (args_k.ph_hi > 4096) grid.sync();
    const int G = gridDim.x;
#define FRESH_IDS() int tid = threadIdx.x; asm volatile("" : "+v"(tid)); const int lane = tid & 63, wave = __builtin_amdgcn_readfirstlane(tid >> 6); (void)lane; (void)wave;
    unsigned char* ws = args_k.ws;
    const int lo = args_k.ph_lo, hi = args_k.ph_hi; (void)lo; (void)hi;
    volatile LAS unsigned* xst = (volatile LAS unsigned*)(lds + LDS_BYTES - 16);
    volatile LAS unsigned* ptbl = (volatile LAS unsigned*)(lds + LDS_BYTES - 512);
    if (threadIdx.x < 4) xst[threadIdx.x] = 0u;
    if (threadIdx.x < N_INPUTS) { const unsigned long long pv = (unsigned long long)args_k.in[threadIdx.x]; ptbl[2 * threadIdx.x] = (unsigned)pv; ptbl[2 * threadIdx.x + 1] = (unsigned)(pv >> 32); }
    __syncthreads();
#if USE_LDS_PTRS
    const ArgsD args{{(const LAS unsigned*)ptbl}, args_k.out, args_k.ws};
#else
    const Args& args = args_k;
#endif
    XcdBarrier xbar = xcd_barrier_post((unsigned*)(ws + WS_CTL) + 4096, xst);
    if (blockIdx.x >= 32 && threadIdx.x == 0) (void)xb_add((unsigned*)(ws + WS_CTL) + 16384 + XB_XCNT(xbar.x), 1u);
#define IN(k) (lo <= (k) && (k) < hi)
#ifndef DUP_MASK
#define DUP_MASK 0
#endif
#ifndef DUP_PM
#define DUP_PM 31
#endif
#ifndef DUP_P2
#define DUP_P2 15
#endif
#ifndef DUP_CHAIN
#define DUP_CHAIN 15
#endif
#ifndef DUP_SKIP_SCAN
#define DUP_SKIP_SCAN 0
#endif
#ifndef DUP_SKIP_SAMPLE
#define DUP_SKIP_SAMPLE 0
#endif
#define REP(bit) for (int rep_ = 0; rep_ <= ((DUP_MASK >> (bit)) & 1); ++rep_) if (rep_ ? (xcd_barrier(xbar), true) : true)
#define SEAM(k) do { if (IN(k) && IN((k) + 1)) xcd_barrier(xbar); } while (0)
#ifdef EXTRA_SYNCS
    for (int es_ = 0; es_ < EXTRA_SYNCS; ++es_) xcd_barrier(xbar);
#endif
    if (IN(0)) REP(8) { FRESH_IDS(); phase_p0a(args, lds, tid, lane, wave, G); __syncthreads(); }
    SEAM(0);
    if (IN(1)) REP(9) { FRESH_IDS(); phase_p0b(args, tid, lane, wave, G); }
    SEAM(1);
    for (int l = 0; l < DEPTH; ++l) {
        const int pb = 2 + 8 * l;
        const float* MODL = (const float*)(ws + WS_MOD) + (size_t)l * NMOD * MODW;
        if (IN(pb + 0)) REP(0) { FRESH_IDS(); if (l == 0) phase_norm<true, true>(args, lds, l, 0, args.in[I_G1] + l * D, MT, tid, lane, wave, G); else phase_norm<false, true>(args, lds, l, 0, args.in[I_G1] + l * D, MT, tid, lane, wave, G); }
        SEAM(pb + 0);
        if (IN(pb + 1)) REP(1) {
            { pg8::Gemm g{(const bf16*)(ws + WS_XN), (const bf16*)(ws + WS_WIN + l * WIN_L), MP, NPROJ, D}; pg8::StaticOrder S; S.init(MP, NPROJ, G, (int)blockIdx.x);
              pg8::EpiBf16<0> E{(bf16*)(ws + WS_PROJ), NPROJ};
              pg8::gemm_phase<pg8::EpiBf16<0>, pg8::StaticOrder, true, true>(lds, g, S, E); }
            { FRESH_IDS();
              constexpr int nun = (MP / 256) * (NPROJ / 256); const int rounds = (nun + G - 1) / G; int first_light = nun - (rounds - 1) * G; if (first_light >= G) first_light = 0;
              if ((int)blockIdx.x >= first_light) { const int nl = G - first_light; const EpiSBf16 E{(bf16*)(ws + WS_PROJ) + (size_t)MP * NPROJ, NPROJ, 0};
                  for (int u = (int)blockIdx.x - first_light; u < NPROJ / 16; u += nl) skinny_unit<1, D>((const bf16*)(ws + WS_XN) + (size_t)MP * D, D, (const bf16*)(ws + WS_WIN + l * WIN_L), u, 0, E, lds, tid, lane, wave); } }
        }
        SEAM(pb + 1);
        if (IN(pb + 2)) REP(2) {
            for (int k_ = 0; k_ < 1536 / 256; ++k_) { const int kk_ = (k_ + (int)(blockIdx.x % 6)) % 6; const int u = (int)blockIdx.x + 256 * kk_;
                if (u < 512) { if (!rep_ || (DUP_P2 & 1)) { FRESH_IDS(); prep_unit(args, lds, l, u >> 6, (u >> 1) & 31, u & 1, tid, lane); } }
                else if (u < 768) { if (!rep_ || (DUP_P2 & 2)) { const int v = u - 512; FRESH_IDS(); KNOB_CONF(confpool_unit(args, lds, l, v >> 5, v & 31, tid, lane, wave)); } }
                else if (u < 1024) { if (!rep_ || (DUP_P2 & 4)) { FRESH_IDS(); KNOB_SAC(sample_ac_unit(args, lds, l, (u - 768) >> 1, (u - 768) & 1, tid, lane)); } }
                else { if (!rep_ || (DUP_P2 & 8)) { FRESH_IDS(); KNOB_SD(sample_delta_unit(args, lds, l, (u - 1024) >> 2, (u - 1024) & 3, tid, lane, wave)); } }
            }
        }
        SEAM(pb + 2);
        if (IN(pb + 3)) REP(3) {
            const int bid = blockIdx.x;
            if (bid < 32) { if (!(rep_ && DUP_SKIP_SCAN)) { FRESH_IDS(); KNOB_SCAN(scan_unit(args, lds, l, bid >> 2, bid & 3, tid, lane, wave)); } }
            else if (!(rep_ && DUP_SKIP_SAMPLE)) {
                FRESH_IDS();
                const int nch = G - 32, ci = bid - 32;
                const bf16* xns = (const bf16*)(ws + WS_XN) + (size_t)MP * D; float* xs = rep_ ? (float*)(ws + WS_SCR) : (float*)(ws + WS_XS); bf16* hs = (bf16*)(ws + WS_HS);
                if (!rep_ || (DUP_CHAIN & 1)) { const EpiSResid E{xs, MODL + 2 * D};
                  for (int u = ci; u < D / 16; u += nch) skinny_unit<1, D>((const bf16*)(ws + WS_MIX) + (size_t)MP * D, D, (const bf16*)(ws + WS_WOUT + l * WOUT_L), u, 0, E, lds, tid, lane, wave); }
                xcd_barrier_subset((unsigned*)(ws + WS_CTL) + 16384, xst + 2, (unsigned)nch);
                if (!rep_ || (DUP_CHAIN & 2)) for (int r = ci * NWAVES + wave; r < NS; r += nch * NWAVES) norm_row(xs + (size_t)r * D, args.in[I_G2] + l * D, MODL + (size_t)(NBAT + r) * MODW + 3 * D, (bf16*)(ws + WS_XN) + (size_t)(MP + r) * D, lane);
                xcd_barrier_subset((unsigned*)(ws + WS_CTL) + 16384, xst + 2, (unsigned)nch);
                if (!rep_ || (DUP_CHAIN & 4)) { const EpiSBf16 E{hs, FF, 2};
                  for (int u = ci; u < FF / 16; u += nch) skinny_unit<1, D>(xns, D, (const bf16*)(ws + WS_W1 + l * W1_L), u, 0, E, lds, tid, lane, wave); }
                xcd_barrier_subset((unsigned*)(ws + WS_CTL) + 16384, xst + 2, (unsigned)nch);
                if (!rep_ || (DUP_CHAIN & 8)) { const EpiSResid E{xs, MODL + 5 * D};
                  for (int u = ci; u < (D / 16) * 4; u += nch) skinny_unit<4, FF>(hs, FF, (const bf16*)(ws + WS_W2 + l * W2_L), u >> 2, u & 3, E, lds, tid, lane, wave); }
                if (l + 1 < DEPTH && !rep_) p0a_weights(args, lds, l + 1, ci * NWAVES + wave, nch * NWAVES, lane, wave);
            }
        }
        SEAM(pb + 3);
        if (IN(pb + 4)) {
            pg8::Gemm g{(const bf16*)(ws + WS_MIX), (const bf16*)(ws + WS_WOUT + l * WOUT_L), MP, D, D}; pg8::StaticOrder S; S.init(MP, D, G, (int)blockIdx.x);
            pg8::Unit u0; u0.pm = 0; u0.pn = 0; S.next(0, u0);
            pg8::EpiResidNorm<0> E{(bf16*)(ws + WS_X), MODL + 2 * D, args.in[I_G2] + l * D, MODL + 3 * D, (bf16*)(ws + WS_XN), nullptr,
                                   (unsigned*)(ws + WS_XCH) + (size_t)l * MP * 4, (unsigned*)(ws + WS_CTL) + 8192 + (l * 64 + u0.pm) * 16};
            pg8::gemm_phase<pg8::EpiResidNorm<0>, pg8::StaticOrder, false, true>(lds, g, S, E);
        }
        SEAM(pb + 4);
        if (IN(pb + 6)) REP(6) {
            pg8::Gemm g{(const bf16*)(ws + WS_XN), (const bf16*)(ws + WS_W1 + l * W1_L), MP, FF, D}; pg8::StaticOrder S; S.init(MP, FF, G, (int)blockIdx.x);
            pg8::EpiBf16<2, true> E{(bf16*)(ws + WS_H), FF};
            pg8::gemm_phase<pg8::EpiBf16<2, true>, pg8::StaticOrder, true, true>(lds, g, S, E);
        }
        SEAM(pb + 6);
        if (IN(pb + 7)) {
            pg8::Gemm g{(const bf16*)(ws + WS_H), (const bf16*)(ws + WS_W2 + l * W2_L), MP, D, FF}; pg8::StaticOrder S; S.init(MP, D, G, (int)blockIdx.x);
            if (l < DEPTH - 1) { pg8::EpiResid E{(bf16*)(ws + WS_X), MODL + 5 * D};
                pg8::gemm_phase<pg8::EpiResid, pg8::StaticOrder, true, true>(lds, g, S, E); }
            else {
                { FRESH_IDS(); (void)tid; phase_final(args, lane, wave, G); }
                pg8::Unit u0; u0.pm = 0; u0.pn = 0; S.next(0, u0);
                pg8::EpiResidNorm<1> E{(bf16*)(ws + WS_X), MODL + 5 * D, args.in[I_GF], nullptr, nullptr, args.out + O_YP,
                                       (unsigned*)(ws + WS_XCH) + (size_t)4 * MP * 4, (unsigned*)(ws + WS_CTL) + 8192 + (4 * 64 + u0.pm) * 16};
                pg8::gemm_phase<pg8::EpiResidNorm<1>, pg8::StaticOrder, false, true>(lds, g, S, E); }
        }
        SEAM(pb + 7);
    }
#undef IN
#undef SEAM
}

extern "C" void kernel_launch(void* const* d_in, const int* in_sizes, int n_in, void* d_out, int out_size, void* d_ws, size_t ws_size, hipStream_t stream) {
    static int grid = 0;
    if (grid == 0) {
        if (n_in != N_INPUTS || (size_t)out_size != O_END || ws_size < WS_END) { fprintf(stderr, "kernel_launch: unexpected shapes: n_in %d out %d ws %zu (need %zu)\n", n_in, out_size, ws_size, (size_t)WS_END); grid = -1; return; }
        int dev = 0, cus = 0, per_cu = 0;
        if (hipGetDevice(&dev) != hipSuccess || hipDeviceGetAttribute(&cus, hipDeviceAttributeMultiprocessorCount, dev) != hipSuccess) { grid = -1; return; }
        if (hipFuncSetAttribute((const void*)hybrid_fwd, hipFuncAttributeMaxDynamicSharedMemorySize, LDS_BYTES) != hipSuccess) { fprintf(stderr, "kernel_launch: hipFuncSetAttribute failed\n"); grid = -1; return; }
        if (hipOccupancyMaxActiveBlocksPerMultiprocessor(&per_cu, (const void*)hybrid_fwd, NTHR, LDS_BYTES) != hipSuccess || per_cu < 1) { fprintf(stderr, "kernel_launch: occupancy query failed (%d)\n", per_cu); (void)hipGetLastError(); per_cu = 1; }
        if (per_cu > 1) per_cu = 1;
        grid = cus * per_cu;
    }
    if (grid != 256) { if (grid >= 0) fprintf(stderr, "kernel_launch: grid %d: this build needs exactly 256 resident workgroups (one per CU)\n", grid); return; }
    if (hipMemsetAsync((char*)d_ws + WS_CTL, 0, 131072, stream) != hipSuccess) { fprintf(stderr, "kernel_launch: memset failed\n"); return; }
    Args a{};
    for (int i = 0; i < N_INPUTS; ++i) a.in[i] = (const float*)d_in[i];
    a.out = (float*)d_out; a.ws = (unsigned char*)d_ws;
#if MK_PER_PHASE
    for (int p = 0; p < N_PHASES; ++p) {
        a.ph_lo = p; a.ph_hi = p + 1;
        void* kargs[] = {&a};
        hipError_t e = hipLaunchCooperativeKernel((const void*)hybrid_fwd, dim3(grid), dim3(NTHR), kargs, LDS_BYTES, stream);
        if (e != hipSuccess) { fprintf(stderr, "kernel_launch: launch of phase %d failed: %s\n", p, hipGetErrorString(e)); break; }
    }
#else
    a.ph_lo = 0; a.ph_hi = N_PHASES;
    void* kargs[] = {&a};
    hipError_t e = hipLaunchCooperativeKernel((const void*)hybrid_fwd, dim3(grid), dim3(NTHR), kargs, LDS_BYTES, stream);
    if (e != hipSuccess) fprintf(stderr, "kernel_launch: cooperative launch failed: %s (grid %d)\n", hipGetErrorString(e), grid);
#endif
}
```

```cpp
#include <hip/hip_runtime.h>
#include <hip/hip_cooperative_groups.h>
#include <cstdio>
#include <cstdint>
namespace cg = cooperative_groups;

constexpr int D = 1024, NBAT = 8, SEQ = 2048, MP = NBAT * SEQ, NS = 128, MT = MP + NS, MPAD = 16640, DEPTH = 4;
constexpr int NPROJ = 2816, NIN = 2824, FF = 4096, NMOD = 136, MODW = 6 * D;
constexpr int PC_POOL = 0, PC_QKV = 256, PC_Z = 1792, PC_GLU = 2304;
constexpr float EPS = 1e-6f;
__device__ __forceinline__ int bidx_of_row(int row) { return row < MP ? (row >> 11) : (row - MP + NBAT); }

namespace pg8 {
#define PG8_LAS __attribute__((address_space(3)))
typedef unsigned short bf16_t;
typedef short bf16x8 __attribute__((ext_vector_type(8)));
typedef float f32x4 __attribute__((ext_vector_type(4)));
typedef unsigned u32x4 __attribute__((ext_vector_type(4)));
constexpr int BM = 256, BK = 64, HALF = 128, HTB = HALF * BK * 2  , STAGE_BYTES = 8 * HTB, NXCD = 8, WGM = 4;

__host__ __device__ __forceinline__ int lds_byte(int r, int c) { const int st = (r >> 4) * 2 + (c >> 5), rr = r & 15, cc = c & 31, ob = rr * 64 + cc * 2; return st * 1024 + (ob ^ (((ob >> 9) & 1) << 5)); }
__host__ __device__ __forceinline__ void stage_rc(int b, int& R, int& C) { const int st = b / 1024, sb = b % 1024, swz = sb ^ (((sb >> 9) & 1) << 5); R = (st >> 1) * 16 + swz / 64; C = (st & 1) * 32 + (swz % 64) / 2; }
__host__ __device__ __forceinline__ int perm32(int rho) { const int n = rho >> 4, i = rho & 15; return 8 * (i >> 2) + 4 * n + (i & 3); }

struct Unit { int pm, pn; };
struct Gemm { const bf16_t* A; const bf16_t* Bt; int M, N, K; };

struct StaticOrder {
    int nM, nN, nwg, G, c;
    __host__ __device__ void init(int M, int N, int G_, int c_) { nM = M / BM; nN = N / BM; nwg = nM * nN; G = G_; c = c_; }
    __host__ __device__ __forceinline__ bool next(int i, Unit& u) const {
        const long L = (long)i * G + c; if (L >= nwg) return false;
        int wgid = (int)L; { const int q = nwg / NXCD, r = nwg % NXCD, xcd = wgid % NXCD, off = wgid / NXCD; wgid = (xcd < r ? xcd * (q + 1) : r * (q + 1) + (xcd - r) * q) + off; }
        const int nig = WGM * nN, gid = wgid / nig, fm = gid * WGM, gsz = (nM - fm) < WGM ? (nM - fm) : WGM;
        u.pm = fm + ((wgid % nig) % gsz); u.pn = (wgid % nig) / gsz; return true;
    }
    __device__ __forceinline__ void a_ready(const Unit&) const {}
    __device__ __forceinline__ void done(const Unit&) const {}
};

__device__ __forceinline__ unsigned cvt_pk_bf16(float lo, float hi) { unsigned r; asm volatile("v_cvt_pk_bf16_f32 %0, %1, %2" : "=v"(r) : "v"(lo), "v"(hi)); return r; }
template <int ACT, bool IMG = false> struct EpiBf16 {
    static constexpr bool PERM = true, AFTER_DRAIN = false, A_IMG = false;
    bf16_t* O; int ldc;
    __device__ __forceinline__ void operator()(const f32x4 (&acc)[2][2][4][2], const Unit& u, int wr, int wc, int fr, int fq) const {
        const int row0 = u.pm * BM + wr * 64 + fr; const int col0 = u.pn * BM + wc * 32 + 8 * fq;
#pragma unroll
        for (int ai = 0; ai < 2; ++ai)
#pragma unroll
            for (int m = 0; m < 4; ++m) { bf16_t* rowp = IMG ? (bf16_t*)((char*)O + ((size_t)(u.pm * (ldc >> 6) + u.pn * 4 + (wc >> 1)) * 2 + ai) * 16384 + ((wr * 4 + m) * 2 + (wc & 1)) * 1024 + ((fr * 64 + 16 * fq) ^ ((fr >> 3) << 5)))
                                                         : O + (size_t)(row0 + ai * HALF + m * 16) * ldc + col0;
#pragma unroll
                for (int bj = 0; bj < 2; ++bj) { f32x4 v0 = acc[ai][bj][m][0], v1 = acc[ai][bj][m][1];
                    if (ACT == 2) {
#pragma unroll
                        for (int e = 0; e < 4; ++e) { float a = fmaxf(v0[e], 0.f), b = fmaxf(v1[e], 0.f); v0[e] = a * a; v1[e] = b * b; } }
                    u32x4 w; w.x = cvt_pk_bf16(v0[0], v0[1]); w.y = cvt_pk_bf16(v0[2], v0[3]); w.z = cvt_pk_bf16(v1[0], v1[1]); w.w = cvt_pk_bf16(v1[2], v1[3]);
                    *(u32x4*)(rowp + (IMG ? bj * 32768 : bj * HALF)) = w; } }
    }
};
__device__ __forceinline__ void unpack8_bf16(const u32x4 w, f32x4& lo, f32x4& hi) {
    lo[0] = __builtin_bit_cast(float, w.x << 16); lo[1] = __builtin_bit_cast(float, w.x & 0xffff0000u); lo[2] = __builtin_bit_cast(float, w.y << 16); lo[3] = __builtin_bit_cast(float, w.y & 0xffff0000u);
    hi[0] = __builtin_bit_cast(float, w.z << 16); hi[1] = __builtin_bit_cast(float, w.z & 0xffff0000u); hi[2] = __builtin_bit_cast(float, w.w << 16); hi[3] = __builtin_bit_cast(float, w.w & 0xffff0000u);
}
__device__ __forceinline__ u32x4 pack8_bf16(const f32x4 lo, const f32x4 hi) { u32x4 w; w.x = cvt_pk_bf16(lo[0], lo[1]); w.y = cvt_pk_bf16(lo[2], lo[3]); w.z = cvt_pk_bf16(hi[0], hi[1]); w.w = cvt_pk_bf16(hi[2], hi[3]); return w; }
struct EpiResid {
    static constexpr bool PERM = true, AFTER_DRAIN = false, A_IMG = true;
    bf16_t* X; const float* gate;
    __device__ __forceinline__ void operator()(const f32x4 (&acc)[2][2][4][2], const Unit& u, int wr, int wc, int fr, int fq) const {
        const int col0 = u.pn * BM + wc * 32 + 8 * fq; const float* gp = gate + (size_t)(u.pm >> 3) * MODW + col0;
#pragma unroll
        for (int bj = 0; bj < 2; ++bj) { const f32x4 g0 = *(const f32x4*)(gp + bj * HALF), g1 = *(const f32x4*)(gp + bj * HALF + 4);
#pragma unroll
            for (int ai = 0; ai < 2; ++ai)
#pragma unroll
                for (int m = 0; m < 4; ++m) { bf16_t* xp = X + (size_t)(u.pm * BM + ai * HALF + wr * 64 + m * 16 + fr) * D + col0 + bj * HALF;
                    f32x4 x0, x1; unpack8_bf16(*(const u32x4*)xp, x0, x1); x0 = x0 + g0 * acc[ai][bj][m][0]; x1 = x1 + g1 * acc[ai][bj][m][1]; *(u32x4*)xp = pack8_bf16(x0, x1); } }
    }
};
template <int MODE> struct EpiResidNorm {
    static constexpr bool PERM = true, AFTER_DRAIN = true, A_IMG = (MODE == 1);
    bf16_t* X; const float* gate; const float* gvec; const float* mod; bf16_t* XN; float* out; unsigned* xbuf; unsigned* cnt;
    __device__ __forceinline__ void fused(f32x4 (&acc)[2][2][4][2], const Unit& u, int wr, int wc, int fr, int fq, PG8_LAS unsigned char* lds, int wid, int lane) const {
        const int col0 = u.pn * BM + wc * 32 + 8 * fq, b = u.pm >> 3;
        const float* gp = gate + (size_t)b * MODW + col0;
        PG8_LAS float* P = (PG8_LAS float*)lds;
        PG8_LAS float* S = (PG8_LAS float*)(lds + 4096);
        float ssum[2][4];
#pragma unroll
        for (int ai = 0; ai < 2; ++ai)
#pragma unroll
            for (int m = 0; m < 4; ++m) ssum[ai][m] = 0.f;
#pragma unroll
        for (int bj = 0; bj < 2; ++bj) { const f32x4 g0 = *(const f32x4*)(gp + bj * HALF), g1 = *(const f32x4*)(gp + bj * HALF + 4);
#pragma unroll
            for (int ai = 0; ai < 2; ++ai)
#pragma unroll
                for (int m = 0; m < 4; ++m) { bf16_t* xp = X + (size_t)(u.pm * BM + ai * HALF + wr * 64 + m * 16 + fr) * D + col0 + bj * HALF;
                    f32x4 x0, x1; unpack8_bf16(*(const u32x4*)xp, x0, x1); x0 = x0 + g0 * acc[ai][bj][m][0]; x1 = x1 + g1 * acc[ai][bj][m][1];
                    if (MODE == 0) *(u32x4*)xp = pack8_bf16(x0, x1);
                    acc[ai][bj][m][0] = x0; acc[ai][bj][m][1] = x1;
                    ssum[ai][m] += ((x0[0] * x0[0] + x0[1] * x0[1]) + (x0[2] * x0[2] + x0[3] * x0[3])) + ((x1[0] * x1[0] + x1[1] * x1[1]) + (x1[2] * x1[2] + x1[3] * x1[3])); } }
#pragma unroll
        for (int ai = 0; ai < 2; ++ai)
#pragma unroll
            for (int m = 0; m < 4; ++m) { float s = ssum[ai][m]; s += __shfl_xor(s, 16); s += __shfl_xor(s, 32); if (fq == 0) P[(ai * HALF + wr * 64 + m * 16 + fr) * 4 + wc] = s; }
        asm volatile("s_waitcnt lgkmcnt(0)" ::: "memory"); __builtin_amdgcn_s_barrier(); asm volatile("" ::: "memory");
        const int row = wid * 32 + (lane & 31);
        if (lane < 32) { const f32x4 p4 = *(const PG8_LAS f32x4*)(P + row * 4); const float t = (p4[0] + p4[1]) + (p4[2] + p4[3]);
            __hip_atomic_store(xbuf + ((size_t)(u.pm * BM + row) * 4 + u.pn), __builtin_bit_cast(unsigned, t), __ATOMIC_RELAXED, __HIP_MEMORY_SCOPE_AGENT); }
        asm volatile("s_waitcnt vmcnt(0)" ::: "memory");
        if (lane == 0) __hip_atomic_fetch_add(cnt, 1u, __ATOMIC_RELAXED, __HIP_MEMORY_SCOPE_AGENT);
        if (wid == 0) { unsigned sp = 0;
            while ((unsigned)__builtin_amdgcn_readfirstlane(__hip_atomic_load(cnt, __ATOMIC_RELAXED, __HIP_MEMORY_SCOPE_AGENT)) < 32u) { __builtin_amdgcn_s_sleep(2); if (++sp > (1u << 20)) break; }
            __builtin_amdgcn_fence(__ATOMIC_ACQUIRE, "agent"); }
        asm volatile("s_waitcnt vmcnt(0) lgkmcnt(0)" ::: "memory"); __builtin_amdgcn_s_barrier(); asm volatile("" ::: "memory");
        if (lane < 32) { const unsigned* sl = xbuf + (size_t)(u.pm * BM + row) * 4; float tot = 0.f;
#pragma unroll
            for (int t = 0; t < 4; ++t) tot += __builtin_bit_cast(float, __hip_atomic_load(sl + t, __ATOMIC_RELAXED, __HIP_MEMORY_SCOPE_AGENT));
            S[row] = rsqrtf(tot * (1.f / D) + EPS); }
        asm volatile("s_waitcnt lgkmcnt(0)" ::: "memory"); __builtin_amdgcn_s_barrier(); asm volatile("" ::: "memory");
        const float* mp = mod + (size_t)b * MODW + col0;
#pragma unroll
        for (int bj = 0; bj < 2; ++bj) { const int off = bj * HALF;
            f32x4 gs0 = *(const f32x4*)(gvec + col0 + off), gs1 = *(const f32x4*)(gvec + col0 + off + 4), sh0 = (f32x4){0.f, 0.f, 0.f, 0.f}, sh1 = sh0;
            if (MODE == 0) { gs0 = gs0 * (*(const f32x4*)(mp + D + off) + 1.f); gs1 = gs1 * (*(const f32x4*)(mp + D + off + 4) + 1.f); sh0 = *(const f32x4*)(mp + off); sh1 = *(const f32x4*)(mp + off + 4); }
#pragma unroll
            for (int ai = 0; ai < 2; ++ai)
#pragma unroll
                for (int m = 0; m < 4; ++m) { const int rl = ai * HALF + wr * 64 + m * 16 + fr; const float rinv = S[rl]; const size_t o = (size_t)(u.pm * BM + rl) * D + col0 + off;
                    const f32x4 h0 = acc[ai][bj][m][0] * rinv * gs0 + sh0, h1 = acc[ai][bj][m][1] * rinv * gs1 + sh1;
                    if (MODE == 0) *(u32x4*)(XN + o) = pack8_bf16(h0, h1);
                    else { *(f32x4*)(out + o) = h0; *(f32x4*)(out + o + 4) = h1; } } }
    }
};
template <class Epi, class Sched, bool ALIGN_EPI = false, bool SP2 = false>
__device__ __forceinline__ void gemm_phase(PG8_LAS unsigned char* lds, const Gemm g, const Sched& S, const Epi& E) {
    int tid_ = threadIdx.x; asm volatile("" : "+v"(tid_)); const int tid = tid_, wid = __builtin_amdgcn_readfirstlane(tid >> 6), lane = tid & 63, wr = wid >> 2, wc = wid & 3, fr = lane & 15, fq = lane >> 4;
    const int K = g.K, nt = K / BK;
    unsigned voffA[2], voffB[2];
#pragma unroll
    for (int i = 0; i < 2; ++i) { int R, C; stage_rc(tid * 16 + i * 8192, R, C); const int Rb = Epi::PERM ? ((R & ~31) + perm32(R & 31)) : R;
        voffA[i] = Epi::A_IMG ? (unsigned)(tid * 16 + i * 8192) : (unsigned)(R * K + C) * 2u; voffB[i] = (unsigned)(Rb * K + C) * 2u; }
    const size_t kstep = (size_t)(BK * 2);
    const size_t hstep = (size_t)HALF * K * 2;
    const size_t kstepA = Epi::A_IMG ? (size_t)32768 : kstep, hstepA = Epi::A_IMG ? (size_t)16384 : hstep;
    const size_t tstep = 2 * hstep;
    const unsigned ldsw = (unsigned)wid * 1024u;
    const int aoff = lds_byte(wr * 64 + fr, fq * 8), boff = lds_byte(wc * 32 + fr, fq * 8);
#define PG8_SA(b, h) (((b) * 2 + (h)) * HTB)
#define PG8_SB(b, h) ((4 + (b) * 2 + (h)) * HTB)
#define PG8_STAGE(bufoff, gbase, voff) do { _Pragma("unroll") for (int _i = 0; _i < 2; ++_i) \
        __builtin_amdgcn_global_load_lds((const unsigned*)((const char*)(gbase) + (voff)[_i]), (PG8_LAS unsigned*)(lds + (bufoff) + ldsw + _i * 8192), 16, 0, 0); } while (0)
#define PG8_LDA(dst, b, h) do { _Pragma("unroll") for (int m = 0; m < 4; ++m) _Pragma("unroll") for (int k = 0; k < 2; ++k) dst[m][k] = *(const PG8_LAS bf16x8*)(lds + PG8_SA(b, h) + aoff + m * 2048 + k * 1024); } while (0)
#define PG8_LDB(dst, b, h) do { _Pragma("unroll") for (int n = 0; n < 2; ++n) _Pragma("unroll") for (int k = 0; k < 2; ++k) dst[n][k] = *(const PG8_LAS bf16x8*)(lds + PG8_SB(b, h) + boff + n * 2048 + k * 1024); } while (0)
#define PG8_MMA(ai, bj, At, Bt) do { __builtin_amdgcn_s_setprio(1); _Pragma("unroll") for (int m = 0; m < 4; ++m) _Pragma("unroll") for (int n = 0; n < 2; ++n) _Pragma("unroll") for (int k = 0; k < 2; ++k) \
        acc[ai][bj][m][n] = __builtin_amdgcn_mfma_f32_16x16x32_bf16(Bt[n][k], At[m][k], acc[ai][bj][m][n], 0, 0, 0); __builtin_amdgcn_s_setprio(0); } while (0)
#define PG8_WAIT_V(n) asm volatile("s_waitcnt vmcnt(" #n ")" ::: "memory")
#define PG8_WAIT_L(n) asm volatile("s_waitcnt lgkmcnt(" #n ")" ::: "memory")
#define PG8_BAR __builtin_amdgcn_s_barrier()
#define PG8_SCHED __builtin_amdgcn_sched_barrier(0)
    Unit cur, nxt; int ui = 0;
    if (!S.next(0, cur)) return;
    f32x4 acc[2][2][4][2];
#pragma unroll
    for (int a = 0; a < 2; ++a)
#pragma unroll
        for (int b = 0; b < 2; ++b)
#pragma unroll
            for (int m = 0; m < 4; ++m)
#pragma unroll
                for (int n = 0; n < 2; ++n) acc[a][b][m][n] = (f32x4){0.f, 0.f, 0.f, 0.f};
    bf16x8 At[4][2], B0[2][2], B1[2][2];
    const char* cA = (const char*)g.A + (size_t)cur.pm * tstep; const char* cB = (const char*)g.Bt + (size_t)cur.pn * tstep;
    S.a_ready(cur);
    if constexpr (SP2) {
        PG8_STAGE(PG8_SB(0, 0), cB, voffB); PG8_STAGE(PG8_SB(0, 1), cB + hstep, voffB); PG8_STAGE(PG8_SA(0, 0), cA, voffA); PG8_STAGE(PG8_SA(0, 1), cA + hstepA, voffA);
        if (wr == 1) PG8_BAR;
        PG8_WAIT_V(2); PG8_BAR;
        PG8_STAGE(PG8_SB(1, 0), cB + kstep, voffB); PG8_STAGE(PG8_SA(1, 0), cA + kstepA, voffA); PG8_STAGE(PG8_SB(1, 1), cB + hstep + kstep, voffB);
        PG8_WAIT_V(6); PG8_BAR;
    } else {
        PG8_STAGE(PG8_SB(0, 0), cB, voffB); PG8_STAGE(PG8_SA(0, 0), cA, voffA); PG8_STAGE(PG8_SB(0, 1), cB + hstep, voffB); PG8_STAGE(PG8_SA(0, 1), cA + hstepA, voffA);
        if (wr == 1) PG8_BAR;
        PG8_WAIT_V(4); PG8_BAR;
        PG8_STAGE(PG8_SB(1, 0), cB + kstep, voffB); PG8_STAGE(PG8_SA(1, 0), cA + kstepA, voffA); PG8_STAGE(PG8_SB(1, 1), cB + hstep + kstep, voffB);
        PG8_WAIT_V(6); PG8_BAR;
    }
    for (;;) {
        const bool has_next = S.next(ui + 1, nxt);
        const char* nA = has_next ? (const char*)g.A + (size_t)nxt.pm * tstep : cA; const char* nB = has_next ? (const char*)g.Bt + (size_t)nxt.pn * tstep : cB;
        for (int t = 0; t < nt; t += 2) {
            const bool last = (t == nt - 2);
            const char* a1 = cA + (size_t)(t + 1) * kstepA;
            const char* a2 = last ? nA : cA + (size_t)(t + 2) * kstepA; const char* b2 = last ? nB : cB + (size_t)(t + 2) * kstep;
            const char* a3 = a2 + kstepA; const char* b3 = b2 + kstep;
            if (last && has_next) S.a_ready(nxt);
            if constexpr (SP2) {
            PG8_LDB(B0, 0, 0); PG8_LDB(B1, 0, 1); PG8_SCHED; PG8_LDA(At, 0, 0); PG8_STAGE(PG8_SA(1, 1), a1 + hstepA, voffA);
            PG8_WAIT_V(8); PG8_WAIT_L(0); PG8_BAR; PG8_MMA(0, 0, At, B0); PG8_MMA(0, 1, At, B1); PG8_BAR; PG8_SCHED;
            PG8_LDA(At, 0, 1); PG8_STAGE(PG8_SB(0, 0), b2, voffB); PG8_STAGE(PG8_SB(0, 1), b2 + hstep, voffB); PG8_STAGE(PG8_SA(0, 0), a2, voffA);
            PG8_WAIT_V(8); PG8_WAIT_L(0); PG8_BAR; PG8_MMA(1, 0, At, B0); PG8_MMA(1, 1, At, B1); PG8_BAR; PG8_SCHED;
            PG8_LDB(B0, 1, 0); PG8_LDB(B1, 1, 1); PG8_SCHED; PG8_LDA(At, 1, 0); PG8_STAGE(PG8_SA(0, 1), a2 + hstepA, voffA);
            PG8_WAIT_V(8); PG8_WAIT_L(0); PG8_BAR; PG8_MMA(0, 0, At, B0); PG8_MMA(0, 1, At, B1); PG8_BAR; PG8_SCHED;
            PG8_LDA(At, 1, 1); PG8_STAGE(PG8_SB(1, 0), b3, voffB); PG8_STAGE(PG8_SB(1, 1), b3 + hstep, voffB); PG8_STAGE(PG8_SA(1, 0), a3, voffA);
            PG8_WAIT_V(8); PG8_WAIT_L(0); PG8_BAR; PG8_MMA(1, 0, At, B0); PG8_MMA(1, 1, At, B1); PG8_BAR; PG8_SCHED;
            } else {
            PG8_LDB(B0, 0, 0); PG8_SCHED; PG8_LDA(At, 0, 0); PG8_STAGE(PG8_SA(1, 1), a1 + hstepA, voffA);
            PG8_WAIT_L(8); PG8_BAR; PG8_WAIT_L(0); PG8_MMA(0, 0, At, B0); PG8_BAR; PG8_SCHED;
            PG8_LDB(B1, 0, 1); PG8_STAGE(PG8_SB(0, 0), b2, voffB);
            PG8_BAR; PG8_WAIT_L(0); PG8_MMA(0, 1, At, B1); PG8_BAR;
            PG8_LDA(At, 0, 1); PG8_STAGE(PG8_SA(0, 0), a2, voffA);
            PG8_BAR; PG8_WAIT_L(0); PG8_MMA(1, 0, At, B0); PG8_BAR; PG8_SCHED;
            PG8_STAGE(PG8_SB(0, 1), b2 + hstep, voffB);
            PG8_WAIT_V(6); PG8_BAR; PG8_MMA(1, 1, At, B1); PG8_BAR;
            PG8_LDB(B0, 1, 0); PG8_SCHED; PG8_LDA(At, 1, 0); PG8_STAGE(PG8_SA(0, 1), a2 + hstepA, voffA);
            PG8_WAIT_L(8); PG8_BAR; PG8_WAIT_L(0); PG8_MMA(0, 0, At, B0); PG8_BAR; PG8_SCHED;
            PG8_LDB(B1, 1, 1); PG8_STAGE(PG8_SB(1, 0), b3, voffB);
            PG8_BAR; PG8_WAIT_L(0); PG8_MMA(0, 1, At, B1); PG8_BAR;
            PG8_LDA(At, 1, 1); PG8_STAGE(PG8_SA(1, 0), a3, voffA);
            PG8_BAR; PG8_WAIT_L(0); PG8_MMA(1, 0, At, B0); PG8_BAR; PG8_SCHED;
            PG8_STAGE(PG8_SB(1, 1), b3 + hstep, voffB);
            PG8_WAIT_V(6); PG8_BAR; PG8_MMA(1, 1, At, B1); PG8_BAR;
            }
        }
        if constexpr (ALIGN_EPI) { if (wr == 0) PG8_BAR; }
        if constexpr (!Epi::AFTER_DRAIN) { E(acc, cur, wr, wc, fr, fq); S.done(cur); }
        if (!has_next) break;
#pragma unroll
        for (int a = 0; a < 2; ++a)
#pragma unroll
            for (int b = 0; b < 2; ++b)
#pragma unroll
                for (int m = 0; m < 4; ++m)
#pragma unroll
                    for (int n = 0; n < 2; ++n) acc[a][b][m][n] = (f32x4){0.f, 0.f, 0.f, 0.f};
        cur = nxt; cA = nA; cB = nB; ++ui;
        if constexpr (ALIGN_EPI) { if (wr == 1) PG8_BAR; }
    }
    PG8_WAIT_V(0);
    if constexpr (!ALIGN_EPI) { if (wr == 0) PG8_BAR; }
    PG8_BAR;
    if constexpr (Epi::AFTER_DRAIN) { E.fused(acc, cur, wr, wc, fr, fq, lds, wid, lane); S.done(cur); }
#undef PG8_SA
#undef PG8_SB
#undef PG8_STAGE
#undef PG8_LDA
#undef PG8_LDB
#undef PG8_MMA
#undef PG8_WAIT_V
#undef PG8_WAIT_L
#undef PG8_BAR
#undef PG8_SCHED
}
}

#define LAS __attribute__((address_space(3)))
typedef unsigned short bf16;
typedef short bf16x8 __attribute__((ext_vector_type(8)));
typedef float f32x4 __attribute__((ext_vector_type(4)));
typedef unsigned u32x4 __attribute__((ext_vector_type(4)));
typedef unsigned u32x2 __attribute__((ext_vector_type(2)));
constexpr int NWAVES = 8, NTHR = 512;
constexpr size_t MiB = 1u << 20;
constexpr size_t WS_CTL = 0, CTL_ZERO_BYTES = 1 * MiB;
constexpr size_t WS_WIN = 2 * MiB, WS_WOUT = 24 * MiB, WS_W1 = 32 * MiB, WS_W2 = 64 * MiB;
constexpr size_t WS_PWT = 96 * MiB, WS_POOLWT = 96 * MiB + 512 * 1024, WS_SC = 97 * MiB, WS_GLAST = 97 * MiB + 512 * 1024;
constexpr size_t WS_MOD = 98 * MiB, WS_BA = 111 * MiB, WS_X = 112 * MiB, WS_XS = 150 * MiB  , WS_XN = 177 * MiB, WS_MIX = 210 * MiB, WS_PROJ = 243 * MiB, WS_PREP = 333 * MiB, WS_H = 243 * MiB, WS_HS = 421 * MiB, WS_SCR = 422 * MiB, WS_XCH = 423 * MiB  , WS_END = 425 * MiB;
constexpr size_t WIN_L = (size_t)NPROJ * D * 2, WOUT_L = (size_t)D * D * 2, W1_L = (size_t)FF * D * 2, W2_L = (size_t)D * FF * 2;
constexpr int PREP_UNIT = 90112, PU_NWC = 0, PU_QG = 16384, PU_QK = 32768, PU_KTT = 40960, PU_UB = 57344;
static_assert(WS_WIN + 4 * WIN_L <= WS_WOUT && WS_MOD + (size_t)DEPTH * NMOD * MODW * 4 <= WS_BA && WS_BA + (size_t)MPAD * 8 * 4 <= WS_X && WS_X + (size_t)MPAD * D * 4 <= WS_XN, "ws map 1");
static_assert(WS_XN + (size_t)MPAD * D * 2 <= WS_MIX && WS_MIX + (size_t)MPAD * D * 2 <= WS_PROJ && WS_PROJ + (size_t)MPAD * NPROJ * 2 <= WS_PREP && WS_PREP + (size_t)1024 * PREP_UNIT <= WS_HS && WS_H + (size_t)MPAD * FF * 2 <= WS_END, "ws map 2");
constexpr int LDS_BYTES = 155648, RING_BYTES = 131072;

constexpr size_t O_YP = 0, O_YS = O_YP + (size_t)MP * D, O_POOLP = O_YS + (size_t)NS * D, O_POOLS = O_POOLP + (size_t)DEPTH * NBAT * 15 * 256, O_QCP = O_POOLS + (size_t)DEPTH * NS * 15 * 256,
    O_QCS = O_QCP + (size_t)DEPTH * NBAT * 3 * 1536, O_DP = O_QCS + (size_t)DEPTH * NS * 3 * 1536, O_DS = O_DP + (size_t)DEPTH * NBAT * 4 * 128 * 128, O_CP = O_DS + (size_t)DEPTH * NS * 4 * 128 * 128,
    O_CS = O_CP + (size_t)DEPTH * NBAT * 30 * 256, O_END = O_CS + (size_t)DEPTH * NS * 30 * 256;
static_assert(O_END == 61333504, "out size");

enum { I_XP = 0, I_XS, I_SPOOL, I_SQKV, I_SDELTA, I_SCONV, I_CP, I_CS, I_WADA, I_BADA, I_G1, I_G2, I_WIN, I_POOLW, I_POOLSC, I_QKVW, I_ALOG, I_DTB, I_DNG, I_CDWW, I_CDWB, I_CLNG, I_CLNB, I_CPW, I_WOUT, I_W1, I_W2, I_GF, N_INPUTS };
struct Args { const float* in[N_INPUTS]; float* out; unsigned char* ws; int ph_lo, ph_hi; };
struct InTbl { const __attribute__((address_space(3))) unsigned* t;
    __device__ __forceinline__ const float* operator[](int i) const { const unsigned lo = __builtin_amdgcn_readfirstlane(t[2 * i]), hi = __builtin_amdgcn_readfirstlane(t[2 * i + 1]); return (const float*)(((unsigned long long)hi << 32) | lo); } };
#ifndef USE_LDS_PTRS
#define USE_LDS_PTRS 0
#endif
#if USE_LDS_PTRS
struct ArgsD { InTbl in; float* out; unsigned char* ws; };
#else
typedef Args ArgsD;
#endif

typedef __bf16 bf16v2_t __attribute__((ext_vector_type(2)));
typedef float f32v2_t __attribute__((ext_vector_type(2)));
__device__ __forceinline__ unsigned cvtpk(float lo, float hi) { bf16v2_t r = __builtin_convertvector((f32v2_t){lo, hi}, bf16v2_t); return __builtin_bit_cast(unsigned, r); }
__device__ __forceinline__ bf16 f2bf(float f) { return (bf16)(cvtpk(f, 0.f) & 0xffffu); }
__device__ __forceinline__ float bf2f(bf16 v) { return __uint_as_float(((unsigned)v) << 16); }
__device__ __forceinline__ float sigmoidf_(float x) { return __builtin_amdgcn_rcpf(1.f + __expf(-x)); }
__device__ __forceinline__ float softplusf_(float x) { return fmaxf(x, 0.f) + __logf(1.f + __expf(-fabsf(x))); }
__device__ __forceinline__ float siluf_(float x) { return x * __builtin_amdgcn_rcpf(1.f + __expf(-x)); }
template <int CTRL> __device__ __forceinline__ float dpp_add(float v) { return v + __builtin_bit_cast(float, __builtin_amdgcn_update_dpp(0, __builtin_bit_cast(int, v), CTRL, 0xf, 0xf, false)); }
__device__ __forceinline__ float wave_sum(float v) {
    v = dpp_add<0xB1>(v); v = dpp_add<0x4E>(v); v = dpp_add<0x141>(v); v = dpp_add<0x140>(v);
    const int iv = __builtin_bit_cast(int, v);
    const float r0 = __builtin_bit_cast(float, __builtin_amdgcn_readlane(iv, 0)), r1 = __builtin_bit_cast(float, __builtin_amdgcn_readlane(iv, 16));
    const float r2 = __builtin_bit_cast(float, __builtin_amdgcn_readlane(iv, 32)), r3 = __builtin_bit_cast(float, __builtin_amdgcn_readlane(iv, 48));
    return (r0 + r1) + (r2 + r3);
}
__device__ __forceinline__ float xreduce64(const float (&v)[64], int lane) {
    float a[32], b[16], c[8], d[4], e[2];
#pragma unroll
    for (int i = 0; i < 32; ++i) { const bool hi = lane & 32; const float keep = hi ? v[i + 32] : v[i], send = hi ? v[i] : v[i + 32]; a[i] = keep + __shfl_xor(send, 32); }
#pragma unroll
    for (int i = 0; i < 16; ++i) { const bool hi = lane & 16; const float keep = hi ? a[i + 16] : a[i], send = hi ? a[i] : a[i + 16]; b[i] = keep + __shfl_xor(send, 16); }
#pragma unroll
    for (int i = 0; i < 8; ++i) { const bool hi = lane & 8; const float keep = hi ? b[i + 8] : b[i], send = hi ? b[i] : b[i + 8]; c[i] = keep + __shfl_xor(send, 8); }
#pragma unroll
    for (int i = 0; i < 4; ++i) { const bool hi = lane & 4; const float keep = hi ? c[i + 4] : c[i], send = hi ? c[i] : c[i + 4]; d[i] = keep + __shfl_xor(send, 4); }
#pragma unroll
    for (int i = 0; i < 2; ++i) { const bool hi = lane & 2; const float keep = hi ? d[i + 2] : d[i], send = hi ? d[i] : d[i + 2]; e[i] = keep + __shfl_xor(send, 2); }
    { const bool hi = lane & 1; const float keep = hi ? e[1] : e[0], send = hi ? e[0] : e[1]; return keep + __shfl_xor(send, 1); }
}
__device__ __forceinline__ bf16x8 mk8(u32x2 lo, u32x2 hi) { u32x4 t; t.x = lo.x; t.y = lo.y; t.z = hi.x; t.w = hi.y; return __builtin_bit_cast(bf16x8, t); }
__device__ __forceinline__ bf16x8 pack8(const f32x4 a, const f32x4 b) { u32x4 t; t.x = cvtpk(a[0], a[1]); t.y = cvtpk(a[2], a[3]); t.z = cvtpk(b[0], b[1]); t.w = cvtpk(b[2], b[3]); return __builtin_bit_cast(bf16x8, t); }
#define MFMA16(a, b, c) __builtin_amdgcn_mfma_f32_16x16x32_bf16((a), (b), (c), 0, 0, 0)

__device__ __forceinline__ void transpose_item(const float* W, int ldw, int ncols, int K, bf16* WT, int row_off, LAS float* scr, int item, int lane) {
    const int nblk = ncols / 32, kb = item / nblk, nb = item % nblk, k0 = 64 * kb, n0 = 32 * nb;
#pragma unroll 8
    for (int i = 0; i < 32; ++i) { const int kk = 2 * i + (lane >> 5); scr[kk * 33 + (lane & 31)] = W[(size_t)(k0 + kk) * ldw + n0 + (lane & 31)]; }
    asm volatile("s_waitcnt lgkmcnt(0)" ::: "memory");
    const int c = lane & 7;
#pragma unroll
    for (int j = 0; j < 4; ++j) { const int n = (lane >> 3) + 8 * j; const LAS float* s = scr + (8 * c) * 33 + n;
        u32x4 o; o.x = cvtpk(s[0 * 33], s[1 * 33]); o.y = cvtpk(s[2 * 33], s[3 * 33]); o.z = cvtpk(s[4 * 33], s[5 * 33]); o.w = cvtpk(s[6 * 33], s[7 * 33]);
        *(u32x4*)(WT + (size_t)(row_off + n0 + n) * K + k0 + 8 * c) = o; }
    asm volatile("s_waitcnt lgkmcnt(0)" ::: "memory");
}
__device__ __forceinline__ void p0a_weights(const ArgsD& a, LAS unsigned char* lds, int l, int gw, int NGW, int lane, int wave) {
    LAS float* scr = (LAS float*)(lds + wave * 16384);
    unsigned char* ws = a.ws;
    constexpr int I_IN1 = 16 * 72, I_IN2 = 16 * 16, I_OUT = 16 * 32, I_1 = 16 * 128, I_2 = 64 * 32, I_PW = 4 * 8, I_PL = 8;
    constexpr int PER = I_IN1 + I_IN2 + I_OUT + I_1 + I_2 + I_PW + I_PL;
    for (int it = gw; it < PER; it += NGW) {
        int r = it;
        const float* win = a.in[I_WIN] + (size_t)l * D * NIN;
        if (r < I_IN1) { transpose_item(win, NIN, 2304, D, (bf16*)(ws + WS_WIN + l * WIN_L), 0, scr, r, lane); continue; } r -= I_IN1;
        if (r < I_IN2) { transpose_item(win + 2312, NIN, 512, D, (bf16*)(ws + WS_WIN + l * WIN_L), 2304, scr, r, lane); continue; } r -= I_IN2;
        if (r < I_OUT) { transpose_item(a.in[I_WOUT] + (size_t)l * D * D, D, D, D, (bf16*)(ws + WS_WOUT + l * WOUT_L), 0, scr, r, lane); continue; } r -= I_OUT;
        if (r < I_1) { transpose_item(a.in[I_W1] + (size_t)l * D * FF, FF, FF, D, (bf16*)(ws + WS_W1 + l * W1_L), 0, scr, r, lane); continue; } r -= I_1;
        if (r < I_2) { transpose_item(a.in[I_W2] + (size_t)l * FF * D, D, D, FF, (bf16*)(ws + WS_W2 + l * W2_L), 0, scr, r, lane); continue; } r -= I_2;
        if (r < I_PW) { transpose_item(a.in[I_CPW] + (size_t)l * 256 * 256, 256, 256, 256, (bf16*)(ws + WS_PWT) + (size_t)l * 65536, 0, scr, r, lane); continue; } r -= I_PW;
        { const int g = r >> 1; transpose_item(a.in[I_POOLW] + (size_t)(l * 4 + g) * 4096, 64, 64, 64, (bf16*)(ws + WS_POOLWT) + (size_t)(l * 4 + g) * 4096, 0, scr, r & 1, lane); }
    }
}
__device__ __forceinline__ void phase_p0a(const ArgsD& a, LAS unsigned char* lds, int tid, int lane, int wave, int G) {
    unsigned char* ws = a.ws;
    p0a_weights(a, lds, 0, blockIdx.x * NWAVES + wave, G * NWAVES, lane, wave);
    const int gt = blockIdx.x * NTHR + tid, NGT = G * NTHR;
    for (int i = gt; i < 144 * 512; i += NGT) { const int r = i >> 9, k = (i & 511) * 2; float v0 = 0.f, v1 = 0.f;
        if (r < NMOD) { const float* cp = r < NBAT ? a.in[I_CP] + (size_t)r * D : a.in[I_CS] + (size_t)(r - NBAT) * D; v0 = siluf_(cp[k]); v1 = siluf_(cp[k + 1]); }
        ((unsigned*)(ws + WS_SC))[i] = cvtpk(v0, v1); }
    for (int i = gt; i < (MPAD - MT) * D / 2; i += NGT) ((unsigned*)(ws + WS_MIX + (size_t)MT * D * 2))[i] = 0u;
}
__device__ __forceinline__ void phase_p0b(const ArgsD& a, int tid, int lane, int wave, int G) {
    const bf16* SC = (const bf16*)(a.ws + WS_SC); float* MOD = (float*)(a.ws + WS_MOD);
    const int q = lane >> 4, c = lane & 15, ct = wave & 3, rt0 = wave >> 2;
    for (int u = blockIdx.x; u < DEPTH * 96; u += G) {
        const int l = u / 96, n0 = (u % 96) * 64 + ct * 16;
        const float* W = a.in[I_WADA] + (size_t)l * D * MODW + n0 + c;
        f32x4 acc[5];
#pragma unroll
        for (int i = 0; i < 5; ++i) acc[i] = (f32x4){0.f, 0.f, 0.f, 0.f};
#pragma unroll 2
        for (int ks = 0; ks < 32; ++ks) {
            const float* wp = W + (size_t)(ks * 32 + q * 8) * MODW;
            float w[8];
#pragma unroll
            for (int j = 0; j < 8; ++j) w[j] = wp[(size_t)j * MODW];
            u32x4 bt; bt.x = cvtpk(w[0], w[1]); bt.y = cvtpk(w[2], w[3]); bt.z = cvtpk(w[4], w[5]); bt.w = cvtpk(w[6], w[7]);
            const bf16x8 bfr = __builtin_bit_cast(bf16x8, bt);
#pragma unroll
            for (int i = 0; i < 5; ++i) { const int rt = rt0 + 2 * i; if (rt < 9) { const bf16x8 af = *(const bf16x8*)(SC + (size_t)(rt * 16 + c) * D + ks * 32 + q * 8); acc[i] = MFMA16(af, bfr, acc[i]); } }
        }
        const float bias = a.in[I_BADA][(size_t)l * MODW + n0 + c];
#pragma unroll
        for (int i = 0; i < 5; ++i) { const int rt = rt0 + 2 * i;
#pragma unroll
            for (int r = 0; r < 4; ++r) { const int row = rt * 16 + q * 4 + r; if (rt < 9 && row < NMOD) MOD[((size_t)l * NMOD + row) * MODW + n0 + c] = acc[i][r] + bias; } }
    }
}
template <bool FIRST, bool WITH_BA>
__device__ __forceinline__ void phase_norm(const ArgsD& a, LAS unsigned char* lds, int l, int modoff, const float* gvec, int nrows, int tid, int lane, int wave, int G) {
    unsigned char* ws = a.ws;
    bf16* XB = (bf16*)(ws + WS_X); float* XS = (float*)(ws + WS_XS); bf16* XN = (bf16*)(ws + WS_XN); float* BA = (float*)(ws + WS_BA);
    const float* MOD = (const float*)(ws + WS_MOD) + (size_t)l * NMOD * MODW + modoff;
    LAS float* wb = (LAS float*)lds;
    if (WITH_BA) {
        const float* win = a.in[I_WIN] + (size_t)l * D * NIN + 2304;
        for (int i = tid; i < 8 * D; i += NTHR) { const int k = i >> 3, cc = i & 7; wb[cc * D + k] = win[(size_t)k * NIN + cc]; }
        __syncthreads();
    }
    f32x4 gv[4];
#pragma unroll
    for (int j = 0; j < 4; ++j) gv[j] = *(const f32x4*)(gvec + 4 * lane + 256 * j);
    f32x4 v[4], vn[4], sh[4], gs[4];
#define NORM_LDROW(dst, r_) do { const int rr_ = (r_) < nrows ? (r_) : nrows - 1; \
        if (FIRST || rr_ >= MP) { const float* xr_ = FIRST ? (rr_ < MP ? a.in[I_XP] + (size_t)rr_ * D : a.in[I_XS] + (size_t)(rr_ - MP) * D) : XS + (size_t)(rr_ - MP) * D; \
            _Pragma("unroll") for (int j = 0; j < 4; ++j) dst[j] = *(const f32x4*)(xr_ + 4 * lane + 256 * j); } \
        else { const bf16* xb_ = XB + (size_t)rr_ * D; \
            _Pragma("unroll") for (int j = 0; j < 4; ++j) { const u32x2 w_ = *(const u32x2*)(xb_ + 4 * lane + 256 * j); dst[j] = (f32x4){__uint_as_float(w_.x << 16), __uint_as_float(w_.x & 0xffff0000u), __uint_as_float(w_.y << 16), __uint_as_float(w_.y & 0xffff0000u)}; } } } while (0)
#define NORM_LDMOD(r_) do { const float* mp_ = MOD + (size_t)bidx_of_row(r_) * MODW; \
        _Pragma("unroll") for (int j = 0; j < 4; ++j) { sh[j] = *(const f32x4*)(mp_ + 4 * lane + 256 * j); gs[j] = gv[j] * (*(const f32x4*)(mp_ + D + 4 * lane + 256 * j) + 1.f); } } while (0)
#define NORM_ROW(row_) do { \
        float s = 0.f; \
        _Pragma("unroll") for (int j = 0; j < 4; ++j) s += (v[j][0] * v[j][0] + v[j][1] * v[j][1]) + (v[j][2] * v[j][2] + v[j][3] * v[j][3]); \
        if (FIRST) { \
            if ((row_) < MP) { _Pragma("unroll") for (int j = 0; j < 4; ++j) *(u32x2*)(XB + (size_t)(row_) * D + 4 * lane + 256 * j) = (u32x2){cvtpk(v[j][0], v[j][1]), cvtpk(v[j][2], v[j][3])}; } \
            else { _Pragma("unroll") for (int j = 0; j < 4; ++j) *(f32x4*)(XS + (size_t)((row_) - MP) * D + 4 * lane + 256 * j) = v[j]; } } \
        const float rinv = rsqrtf(wave_sum(s) * (1.f / D) + EPS); \
        u32x2* o8 = (u32x2*)(XN + (size_t)(row_) * D) + lane; \
        float ba[8]; \
        _Pragma("unroll") for (int e = 0; e < 8; ++e) ba[e] = 0.f; \
        _Pragma("unroll") for (int j = 0; j < 4; ++j) { \
            const f32x4 h = v[j] * rinv * gs[j] + sh[j]; \
            o8[64 * j] = (u32x2){cvtpk(h[0], h[1]), cvtpk(h[2], h[3])}; \
            if (WITH_BA) { _Pragma("unroll") for (int e = 0; e < 8; ++e) { const f32x4 w4 = *(const LAS f32x4*)(wb + e * D + 4 * lane + 256 * j); ba[e] += (h[0] * w4[0] + h[1] * w4[1]) + (h[2] * w4[2] + h[3] * w4[3]); } } } \
        if (WITH_BA) { \
            _Pragma("unroll") for (int e = 0; e < 8; ++e) ba[e] = wave_sum(ba[e]); \
            float outv = ba[0]; \
            _Pragma("unroll") for (int e = 1; e < 8; ++e) outv = (lane == e) ? ba[e] : outv; \
            if (lane < 8) BA[(size_t)(row_) * 8 + lane] = outv; } } while (0)
    for (int r0 = (blockIdx.x * NWAVES + wave) * 8; r0 < MP; r0 += G * NWAVES * 8) {
        NORM_LDMOD(r0);
        NORM_LDROW(vn, r0);
#pragma unroll 1
        for (int i = 0; i < 8; ++i) {
#pragma unroll
            for (int j = 0; j < 4; ++j) v[j] = vn[j];
            if (i < 7) NORM_LDROW(vn, r0 + i + 1);
            NORM_ROW(r0 + i);
        }
    }
    for (int row = MP + blockIdx.x * NWAVES + wave; row < nrows; row += G * NWAVES) {
        NORM_LDMOD(row);
        NORM_LDROW(v, row);
        NORM_ROW(row);
    }
#undef NORM_LDROW
#undef NORM_LDMOD
#undef NORM_ROW
    if (WITH_BA) __syncthreads();
}
__device__ __forceinline__ void phase_final(const ArgsD& a, int lane, int wave, int G) {
    const float* X = (const float*)(a.ws + WS_XS) - (size_t)MP * D; const float* gf = a.in[I_GF];
    f32x4 gv[4];
#pragma unroll
    for (int j = 0; j < 4; ++j) gv[j] = *(const f32x4*)(gf + 4 * lane + 256 * j);
    for (int row = MP + blockIdx.x * NWAVES + wave; row < MT; row += G * NWAVES) {
        const float* xr = X + (size_t)row * D; f32x4 v[4]; float s = 0.f;
#pragma unroll
        for (int j = 0; j < 4; ++j) { v[j] = *(const f32x4*)(xr + 4 * lane + 256 * j); s += (v[j][0] * v[j][0] + v[j][1] * v[j][1]) + (v[j][2] * v[j][2] + v[j][3] * v[j][3]); }
        const float rinv = rsqrtf(wave_sum(s) * (1.f / D) + EPS);
#pragma unroll
        for (int j = 0; j < 4; ++j) *(f32x4*)(a.out + O_YP + (size_t)row * D + 4 * lane + 256 * j) = v[j] * rinv * gv[j];
    }
}

__device__ __forceinline__ int kpos(int k) { return (k & ~31) | (8 * ((k >> 2) & 3) + 4 * ((k >> 4) & 1) + (k & 3)); }
__device__ __forceinline__ int swz256(int row, int e) { return ((((e >> 3) ^ row) & 15) << 3) | (e & 7); }
__device__ __forceinline__ int swz128(int row, int e) { return ((((e >> 3) ^ (row >> 1)) & 7) << 3) | (e & 7); }
constexpr int P2_STGP = 1056, P2_TT = 0, P2_QKT = 18432, P2_QK = 71040, P2_SC = 144768;
template <int NOCT_LOG2, int NITER>
__device__ __forceinline__ void stage_rows(const bf16* pseq, int tfirst, int nrows, int col0, LAS unsigned char* dst, int pitch, int tid) {
    const int total = nrows << NOCT_LOG2;
    u32x4 v[NITER];
#pragma unroll
    for (int i = 0; i < NITER; ++i) { int it = tid + NTHR * i; it = it < total ? it : total - 1; const int r = it >> NOCT_LOG2, o = it & ((1 << NOCT_LOG2) - 1); const int t = tfirst + r, tc = t < 0 ? 0 : t;
        v[i] = *(const u32x4*)(pseq + (size_t)tc * NPROJ + col0 + 8 * o); if (t < 0) v[i] = (u32x4){0u, 0u, 0u, 0u}; }
#pragma unroll
    for (int i = 0; i < NITER; ++i) { const int it = tid + NTHR * i; if (it < total) { const int r = it >> NOCT_LOG2, o = it & ((1 << NOCT_LOG2) - 1); *(LAS u32x4*)(dst + r * pitch + o * 16) = v[i]; } }
}
__device__ __forceinline__ void unpack8(const u32x2 lo, const u32x2 hi, float (&f)[8]) {
    f[0] = __uint_as_float(lo.x << 16); f[1] = __uint_as_float(lo.x & 0xffff0000u); f[2] = __uint_as_float(lo.y << 16); f[3] = __uint_as_float(lo.y & 0xffff0000u);
    f[4] = __uint_as_float(hi.x << 16); f[5] = __uint_as_float(hi.x & 0xffff0000u); f[6] = __uint_as_float(hi.y << 16); f[7] = __uint_as_float(hi.y & 0xffff0000u);
}
__device__ __forceinline__ void prep_unit(const ArgsD& a, LAS unsigned char* lds, int l, int b, int n, int hp, int tid, int lane) {
    unsigned char* ws = a.ws;
    const bf16* pseq = (const bf16*)(ws + WS_PROJ) + (size_t)(b * SEQ) * NPROJ; const float* BA = (const float*)(ws + WS_BA);
    const int half = tid >> 8, ht = tid & 255, h0 = 2 * hp, h = h0 + half, t0 = 64 * n, row0 = b * SEQ + t0;
    const int unit = (b * 32 + n) * 4 + h;
    unsigned char* pu = ws + WS_PREP + (size_t)unit * PREP_UNIT;
    LAS bf16* qh = (LAS bf16*)(lds + P2_QK + half * 36864); LAS bf16* kh = qh + 9216; LAS float* Tt = (LAS float*)(lds + P2_TT + half * 16384);
    LAS bf16* qkt = (LAS bf16*)(lds + P2_QKT + half * 9216);
    LAS float* sBeta = (LAS float*)(lds + P2_SC + half * 4096); LAS float* sG = sBeta + 64; LAS float* sP = sBeta + 128  ; LAS float* sR = sBeta + 384  ;
    const int wv = ht >> 6;
    stage_rows<5, 5>(pseq, t0 - 3, 67, PC_QKV + h0 * 128, lds, P2_STGP, tid);
    stage_rows<5, 5>(pseq, t0 - 3, 67, PC_QKV + 512 + h0 * 128, lds + 512, P2_STGP, tid);
    if (ht < 64) {
        const float bl = BA[(size_t)(row0 + ht) * 8 + h], al = BA[(size_t)(row0 + ht) * 8 + 4 + h];
        const float beta = sigmoidf_(bl);
        const float xg = al + a.in[I_DTB][l * 4 + h];
        const float sp = softplusf_(xg);
        float g = -__expf(a.in[I_ALOG][l * 4 + h]) * sp;
#pragma unroll
        for (int o = 1; o < 64; o <<= 1) { const float t = __shfl_up(g, o); if (lane >= o) g += t; }
        sBeta[ht] = beta; sG[ht] = g;
    }
    __syncthreads();
    const bool isq = ht < 128; const int ch = ht & 127;
    const float* cw = a.in[I_QKVW] + (size_t)l * 4 * 1536;
    float val[64];
    {
        const int wcol = (isq ? 0 : 512) + h * 128 + ch;
        const float w0 = cw[wcol], w1 = cw[1536 + wcol], w2 = cw[2 * 1536 + wcol], w3 = cw[3 * 1536 + wcol];
        const LAS bf16* sp = (const LAS bf16*)lds + (isq ? 0 : 256) + half * 128 + ch;
        float x0 = bf2f(sp[0]), x1 = bf2f(sp[528]), x2 = bf2f(sp[2 * 528]);
#pragma unroll
        for (int t = 0; t < 64; ++t) { const float x3 = bf2f(sp[(t + 3) * 528]); val[t] = siluf_((w0 * x0 + w1 * x1) + (w2 * x2 + w3 * x3)); x0 = x1; x1 = x2; x2 = x3; }
        float sq[64];
#pragma unroll
        for (int t = 0; t < 64; ++t) sq[t] = val[t] * val[t];
        const float tot = xreduce64(sq, lane);
        sP[wv * 64 + lane] = tot;
    }
    __syncthreads();
    if (ht < 128) { const int which = ht >> 6, t = ht & 63; const float ss = sP[(2 * which) * 64 + t] + sP[(2 * which + 1) * 64 + t]; sR[which * 64 + t] = rsqrtf(ss + EPS) * (which == 0 ? 0.08838834764831845f : 1.f); }
    stage_rows<5, 5>(pseq, t0 - 3, 67, PC_QKV + 1024 + h0 * 128, lds, P2_STGP, tid);
    __syncthreads();
    const float Glast = sG[63];
    {
        LAS bf16* dst = isq ? qh : kh;
        const LAS float* rr = sR + (isq ? 0 : 64);
#pragma unroll
        for (int t = 0; t < 64; ++t) { val[t] *= rr[t]; dst[t * 144 + ch] = f2bf(val[t]); }
        if (!isq) {
            u32x4* kt = (u32x4*)(pu + PU_KTT + ch * 128); const int ksw = (ch >> 1) & 7;
#pragma unroll
            for (int t8 = 0; t8 < 8; ++t8) { float e[8];
#pragma unroll
                for (int j = 0; j < 8; ++j) { const int tk = 32 * (t8 >> 2) + 16 * (j >> 2) + 4 * (t8 & 3) + (j & 3); e[j] = val[tk] * __expf(Glast - sG[tk]); }
                u32x4 o; o.x = cvtpk(e[0], e[1]); o.y = cvtpk(e[2], e[3]); o.z = cvtpk(e[4], e[5]); o.w = cvtpk(e[6], e[7]); kt[t8 ^ ksw] = o; }
#pragma unroll
            for (int t = 0; t < 64; ++t) val[t] *= sBeta[t] * __expf(sG[t]);
        }
    }
    if (isq) {
        const int wcol = 1024 + h * 128 + ch;
        const float w0 = cw[wcol], w1 = cw[1536 + wcol], w2 = cw[2 * 1536 + wcol], w3 = cw[3 * 1536 + wcol];
        const LAS bf16* sp = (const LAS bf16*)lds + half * 128 + ch;
        float x0 = bf2f(sp[0]), x1 = bf2f(sp[528]), x2 = bf2f(sp[2 * 528]);
#pragma unroll
        for (int t = 0; t < 64; ++t) { const float x3 = bf2f(sp[(t + 3) * 528]); val[t] = siluf_((w0 * x0 + w1 * x1) + (w2 * x2 + w3 * x3)) * sBeta[t]; x0 = x1; x1 = x2; x2 = x3; }
    }
    __syncthreads();
    LAS bf16* T16 = (LAS bf16*)(lds + half * 9216);
    LAS float* Dt = (LAS float*)(lds + 36864 + (tid >> 6) * 1024);
    LAS bf16* Dv = (LAS bf16*)(lds + 45056 + half * 2048);
    {
        const int q = lane >> 4, c = lane & 15, mi = wv;
        f32x4 kk[4], qk[4];
#pragma unroll
        for (int ni = 0; ni < 4; ++ni) { kk[ni] = (f32x4){0.f, 0.f, 0.f, 0.f}; qk[ni] = (f32x4){0.f, 0.f, 0.f, 0.f}; }
#pragma unroll
        for (int ks = 0; ks < 4; ++ks) {
            const bf16x8 ak = *(const LAS bf16x8*)(kh + (16 * mi + c) * 144 + ks * 32 + q * 8);
            const bf16x8 aq = *(const LAS bf16x8*)(qh + (16 * mi + c) * 144 + ks * 32 + q * 8);
#pragma unroll
            for (int ni = 0; ni < 4; ++ni) { const bf16x8 bk = *(const LAS bf16x8*)(kh + (16 * ni + c) * 144 + ks * 32 + q * 8); kk[ni] = MFMA16(ak, bk, kk[ni]); qk[ni] = MFMA16(aq, bk, qk[ni]); }
        }
#pragma unroll
        for (int ni = 0; ni < 4; ++ni) {
            float tn[4];
#pragma unroll
            for (int r = 0; r < 4; ++r) { const int i = 16 * mi + 4 * q + r, j = 16 * ni + c;
                const float dec = __expf(fminf(sG[i] - sG[j], 0.f));
                tn[r] = (i > j) ? -(sBeta[i] * kk[ni][r] * dec) : 0.f;
                T16[i * 72 + j] = f2bf(tn[r]);
                qkt[i * 72 + j] = f2bf((i >= j) ? qk[ni][r] * dec : 0.f); }
            if (ni == mi) {
#pragma unroll
                for (int r = 0; r < 4; ++r) Dt[(4 * q + r) * 16 + c] = tn[r];
            }
        }
        {
            float x[16];
#pragma unroll
            for (int r = 0; r < 16; ++r) { float s = (r == c) ? 1.f : 0.f;
#pragma unroll
                for (int s4 = 0; s4 < (r + 3) / 4; ++s4) { const f32x4 tr = *(const LAS f32x4*)(Dt + r * 16 + 4 * s4);
#pragma unroll
                    for (int e = 0; e < 4; ++e) if (4 * s4 + e < r) s += tr[e] * x[4 * s4 + e]; }
                x[r] = s; }
            if (lane < 16) {
#pragma unroll
                for (int r = 0; r < 16; ++r) Dv[(wv * 16 + r) * 16 + c] = f2bf(x[r]);
            }
        }
    }
#pragma unroll
    for (int i = 0; i < 4; ++i) { const int p = ht + 256 * i, t = p >> 4, L = p & 15, e0 = 32 * (L >> 2) + 4 * (L & 3);
        const u32x2 lo = *(const LAS u32x2*)(qh + t * 144 + e0), hi = *(const LAS u32x2*)(qh + t * 144 + e0 + 16);
        float f[8]; unpack8(lo, hi, f); const float eg = __expf(sG[t]);
        u32x4 o; o.x = cvtpk(f[0] * eg, f[1] * eg); o.y = cvtpk(f[2] * eg, f[3] * eg); o.z = cvtpk(f[4] * eg, f[5] * eg); o.w = cvtpk(f[6] * eg, f[7] * eg);
        *(u32x4*)(pu + PU_QG + t * 256 + ((L ^ (t & 15)) << 4)) = o; }
    __syncthreads();
    typedef short s16x4 __attribute__((ext_vector_type(4)));
    s16x4 Xb[4][4];
    {
        LAS bf16* rT = qh;
#pragma unroll
        for (int t8 = 0; t8 < 8; ++t8) { u32x4 o; o.x = cvtpk(val[8 * t8], val[8 * t8 + 1]); o.y = cvtpk(val[8 * t8 + 2], val[8 * t8 + 3]); o.z = cvtpk(val[8 * t8 + 4], val[8 * t8 + 5]); o.w = cvtpk(val[8 * t8 + 6], val[8 * t8 + 7]);
            *(LAS u32x4*)(rT + ht * 72 + 8 * t8) = o; }
        const int q = lane >> 4, c = lane & 15;
        f32x4* ub = (f32x4*)(pu + PU_UB);
#pragma unroll
        for (int I = 0; I < 4; ++I) {
            s16x4 ta[4];
#pragma unroll
            for (int J = 0; J < 4; ++J) if (J < I) ta[J] = *(const LAS s16x4*)(T16 + (16 * I + c) * 72 + 16 * J + 4 * q);
            const s16x4 da = *(const LAS s16x4*)(Dv + (I * 16 + c) * 16 + 4 * q);
#pragma unroll
            for (int k = 0; k < 4; ++k) {
                const u32x2 rv = *(const LAS u32x2*)(rT + (64 * wv + 16 * k + c) * 72 + 16 * I + 4 * q);
                f32x4 acc = (f32x4){__uint_as_float(rv.x << 16), __uint_as_float(rv.x & 0xffff0000u), __uint_as_float(rv.y << 16), __uint_as_float(rv.y & 0xffff0000u)};
#pragma unroll
                for (int J = 0; J < 4; ++J) if (J < I) acc = __builtin_amdgcn_mfma_f32_16x16x16bf16_1k(ta[J], Xb[J][k], acc, 0, 0, 0);
                u32x2 yb; yb.x = cvtpk(acc[0], acc[1]); yb.y = cvtpk(acc[2], acc[3]);
                const f32x4 x = __builtin_amdgcn_mfma_f32_16x16x16bf16_1k(da, __builtin_bit_cast(s16x4, yb), (f32x4){0.f, 0.f, 0.f, 0.f}, 0, 0, 0);
                u32x2 xb; xb.x = cvtpk(x[0], x[1]); xb.y = cvtpk(x[2], x[3]);
                Xb[I][k] = __builtin_bit_cast(s16x4, xb);
                if (isq) ub[((4 * wv + k) * 4 + I) * 64 + lane] = x;
            }
        }
    }
#pragma unroll
    for (int i = 0; i < 2; ++i) { const int p = ht + 256 * i, t = p >> 3, L = p & 7, e0 = 32 * (L >> 2) + 4 * (L & 3);
        const u32x2 lo = *(const LAS u32x2*)(qkt + t * 72 + e0), hi = *(const LAS u32x2*)(qkt + t * 72 + e0 + 16);
        u32x4 o; o.x = lo.x; o.y = lo.y; o.z = hi.x; o.w = hi.y; *(u32x4*)(pu + PU_QK + t * 128 + ((L ^ ((t >> 1) & 7)) << 4)) = o; }
    if (ht == 0) ((float*)(ws + WS_GLAST))[unit] = __expf(Glast);
    __syncthreads();
    LAS bf16* nt = (LAS bf16*)(lds + half * 17408);
    if (!isq) {
        const int q = lane >> 4, c = lane & 15;
#pragma unroll
        for (int I = 0; I < 4; ++I)
#pragma unroll
            for (int k = 0; k < 4; ++k)
#pragma unroll
                for (int r = 0; r < 4; ++r) *(LAS unsigned short*)(nt + (16 * I + 4 * q + r) * 136 + 64 * (wv - 2) + 16 * k + c) = (unsigned short)((unsigned short)Xb[I][k][r] ^ 0x8000u);
    }
    __syncthreads();
#pragma unroll
    for (int i = 0; i < 4; ++i) { const int p = ht + 256 * i, t = p >> 4, L = p & 15, e0 = 32 * (L >> 2) + 4 * (L & 3);
        const u32x2 lo = *(const LAS u32x2*)(nt + t * 136 + e0), hi = *(const LAS u32x2*)(nt + t * 136 + e0 + 16);
        u32x4 o; o.x = lo.x; o.y = lo.y; o.z = hi.x; o.w = hi.y; *(u32x4*)(pu + PU_NWC + t * 256 + ((L ^ (t & 15)) << 4)) = o; }
    __syncthreads();
}

constexpr int CP_G = 0, CP_AS = 96256, CP_OT = 0  ;
__device__ __forceinline__ void confpool_unit(const ArgsD& a, LAS unsigned char* lds, int l, int b, int n, int tid, int lane, int wave) {
    unsigned char* ws = a.ws;
    const bf16* pseq = (const bf16*)(ws + WS_PROJ) + (size_t)(b * SEQ) * NPROJ; bf16* MIX = (bf16*)(ws + WS_MIX);
    const int c = tid & 255, th = tid >> 8, t0 = 64 * n, row0 = b * SEQ + t0;
    LAS float* gl = (LAS float*)(lds + CP_G); LAS bf16* As = (LAS bf16*)(lds + CP_AS); LAS bf16* ot = (LAS bf16*)(lds + CP_OT);
    const int q = lane >> 4, cc = lane & 15;
    {
        u32x4 p1[6], p2[6];
#pragma unroll
        for (int i = 0; i < 6; ++i) { int it = tid + NTHR * i; it = it < 94 * 32 ? it : 94 * 32 - 1; const int r = it >> 5, o = it & 31; const int t = t0 - 30 + r, tc = t < 0 ? 0 : t;
            const bf16* pp = pseq + (size_t)tc * NPROJ + PC_GLU + 8 * o; p1[i] = *(const u32x4*)pp; p2[i] = *(const u32x4*)(pp + 256); }
#pragma unroll
        for (int i = 0; i < 6; ++i) { const int it = tid + NTHR * i; if (it < 94 * 32) { const int r = it >> 5, o = it & 31; const int t = t0 - 30 + r;
            float f1[8], f2[8]; unpack8((u32x2){p1[i].x, p1[i].y}, (u32x2){p1[i].z, p1[i].w}, f1); unpack8((u32x2){p2[i].x, p2[i].y}, (u32x2){p2[i].z, p2[i].w}, f2);
            f32x4 g0, g1;
#pragma unroll
            for (int e = 0; e < 4; ++e) { g0[e] = t >= 0 ? f1[e] * sigmoidf_(f2[e]) : 0.f; g1[e] = t >= 0 ? f1[4 + e] * sigmoidf_(f2[4 + e]) : 0.f; }
            *(LAS f32x4*)(gl + r * 256 + 8 * o) = g0; *(LAS f32x4*)(gl + r * 256 + 8 * o + 4) = g1; } }
    }
    __syncthreads();
    {
        float g[62];
#pragma unroll
        for (int i = 0; i < 62; ++i) g[i] = gl[(32 * th + i) * 256 + c];
        if (n == 31 && th == 1) { float* o = a.out + O_CP + ((size_t)(l * NBAT + b) * 30) * 256 + c;
#pragma unroll
            for (int r = 0; r < 30; ++r) o[r * 256] = g[32 + r]; }
        const float* dw = a.in[I_CDWW] + (size_t)l * 31 * 256 + c;
        float dc[32]; const float bias = a.in[I_CDWB][l * 256 + c];
        {
            typedef float f32x2s __attribute__((ext_vector_type(2)));
            f32x2s gE[31], gO[30], d2[16];
#pragma unroll
            for (int p = 0; p < 31; ++p) gE[p] = (f32x2s){g[2 * p], g[2 * p + 1]};
#pragma unroll
            for (int p = 0; p < 30; ++p) gO[p] = (f32x2s){g[2 * p + 1], g[2 * p + 2]};
#pragma unroll
            for (int p = 0; p < 16; ++p) d2[p] = (f32x2s){bias, bias};
#pragma unroll
            for (int j = 0; j < 31; ++j) { const float w = dw[j * 256]; const f32x2s w2 = (f32x2s){w, w};
#pragma unroll
                for (int p = 0; p < 16; ++p) d2[p] += w2 * ((j & 1) ? gO[p + (j - 1) / 2] : gE[p + j / 2]); }
#pragma unroll
            for (int p = 0; p < 16; ++p) { dc[2 * p] = d2[p][0]; dc[2 * p + 1] = d2[p][1]; }
        }
        float st[64];
#pragma unroll
        for (int i = 0; i < 32; ++i) { st[i] = dc[i]; st[32 + i] = dc[i] * dc[i]; }
        const float red = xreduce64(st, lane);
        const float lg = a.in[I_CLNG][l * 256 + c], lb = a.in[I_CLNB][l * 256 + c];
#pragma unroll
        for (int i = 0; i < 32; ++i) { const float mean = __shfl(red, i) * (1.f / 64.f); const float ex2 = __shfl(red, 32 + i) * (1.f / 64.f);
            const float var = fmaxf(ex2 - mean * mean, 0.f); const float dn = (dc[i] - mean) * rsqrtf(var + EPS) * lg + lb;
            As[(32 * th + i) * 272 + c] = f2bf(siluf_(dn)); }
    }
    __syncthreads();
    u32x4 pu_[5];
#pragma unroll
    for (int i = 0; i < 5; ++i) { int it = tid + NTHR * i; it = it < 79 * 32 ? it : 79 * 32 - 1; const int r = it >> 5, o = it & 31; const int t = t0 - 15 + r, tc = t < 0 ? 0 : t;
        pu_[i] = *(const u32x4*)(pseq + (size_t)tc * NPROJ + PC_POOL + 8 * o); if (t < 0) pu_[i] = (u32x4){0u, 0u, 0u, 0u}; }
    {
        const bf16* PWT = (const bf16*)(ws + WS_PWT) + (size_t)l * 65536;
        bf16x8 bfr[8][2];
#pragma unroll
        for (int ks = 0; ks < 8; ++ks)
#pragma unroll
            for (int j = 0; j < 2; ++j) bfr[ks][j] = *(const bf16x8*)(PWT + (size_t)((2 * wave + j) * 16 + cc) * 256 + ks * 32 + q * 8);
        f32x4 acc[4][2];
#pragma unroll
        for (int m = 0; m < 4; ++m) { acc[m][0] = (f32x4){0.f, 0.f, 0.f, 0.f}; acc[m][1] = (f32x4){0.f, 0.f, 0.f, 0.f}; }
#pragma unroll
        for (int ks = 0; ks < 8; ++ks)
#pragma unroll
            for (int m = 0; m < 4; ++m) { const bf16x8 af = *(const LAS bf16x8*)(As + (16 * m + cc) * 272 + ks * 32 + q * 8); acc[m][0] = MFMA16(af, bfr[ks][0], acc[m][0]); acc[m][1] = MFMA16(af, bfr[ks][1], acc[m][1]); }
#pragma unroll
        for (int m = 0; m < 4; ++m)
#pragma unroll
            for (int j = 0; j < 2; ++j)
#pragma unroll
                for (int r = 0; r < 4; ++r) ot[(16 * m + 4 * q + r) * 264 + (2 * wave + j) * 16 + cc] = f2bf(acc[m][j][r]);
    }
    LAS float* ul = (LAS float*)(lds + 33792);
    (void)ul;
    LAS bf16* ub16 = (LAS bf16*)(lds + 33792);
#pragma unroll
    for (int i = 0; i < 5; ++i) { const int it = tid + NTHR * i; if (it < 79 * 32) { const int r = it >> 5, o = it & 31; *(LAS u32x4*)(ub16 + r * 256 + 8 * o) = pu_[i]; } }
    __syncthreads();
    {
#pragma unroll
        for (int i = 0; i < 4; ++i) { const int p = tid + NTHR * i, t = p >> 5, o = p & 31; *(u32x4*)(MIX + (size_t)(row0 + t) * D + 768 + 8 * o) = *(const LAS u32x4*)(ot + t * 264 + 8 * o); }
        float cs[48]; float ucur[32]; float keep[15];
        float run = 0.f; cs[0] = 0.f;
#pragma unroll
        for (int i = 0; i < 47; ++i) { const float v = bf2f(ub16[(32 * th + i) * 256 + c]); run += v; cs[i + 1] = run; if (i >= 15) ucur[i - 15] = v; if (i >= 32) keep[i - 32] = v; }
        if (n == 31 && th == 1) { float* o = a.out + O_POOLP + ((size_t)(l * NBAT + b) * 15) * 256 + c;
#pragma unroll
            for (int r = 0; r < 15; ++r) o[r * 256] = keep[r]; }
        const int gi = c >> 6, tb = t0 + 32 * th;
#pragma unroll
        for (int i = 0; i < 32; ++i) {
            const float lo = gi == 0 ? cs[14 + i] : (gi == 1 ? cs[12 + i] : (gi == 2 ? cs[8 + i] : cs[i]));
            const float s = cs[16 + i] - lo; const int w = 2 << gi; const int tabs = tb + i; const float cnt = (float)(tabs + 1 < w ? tabs + 1 : w);
            As[(32 * th + i) * 272 + c] = f2bf(s * __builtin_amdgcn_rcpf(cnt) - ucur[i]); }
    }
    __syncthreads();
    {
        const bf16* PLT = (const bf16*)(ws + WS_POOLWT) + (size_t)l * 16384;
        f32x4 acc[4][2];
#pragma unroll
        for (int m = 0; m < 4; ++m) { acc[m][0] = (f32x4){0.f, 0.f, 0.f, 0.f}; acc[m][1] = (f32x4){0.f, 0.f, 0.f, 0.f}; }
        const int g = (2 * wave) >> 2;
        bf16x8 bfr[2][2];
#pragma unroll
        for (int ks = 0; ks < 2; ++ks)
#pragma unroll
            for (int j = 0; j < 2; ++j) { const int ct = 2 * wave + j, j0 = 16 * (ct & 3); bfr[ks][j] = *(const bf16x8*)(PLT + (size_t)g * 4096 + (j0 + cc) * 64 + ks * 32 + q * 8); }
#pragma unroll
        for (int ks = 0; ks < 2; ++ks)
#pragma unroll
            for (int m = 0; m < 4; ++m) { const bf16x8 af = *(const LAS bf16x8*)(As + (16 * m + cc) * 272 + g * 64 + ks * 32 + q * 8); acc[m][0] = MFMA16(af, bfr[ks][0], acc[m][0]); acc[m][1] = MFMA16(af, bfr[ks][1], acc[m][1]); }
#pragma unroll
        for (int j = 0; j < 2; ++j) { const int col = (2 * wave + j) * 16 + cc; const float sc = a.in[I_POOLSC][l * 256 + col];
#pragma unroll
            for (int m = 0; m < 4; ++m)
#pragma unroll
                for (int r = 0; r < 4; ++r) ot[(16 * m + 4 * q + r) * 264 + col] = f2bf(acc[m][j][r] * sc); }
    }
    __syncthreads();
#pragma unroll
    for (int i = 0; i < 4; ++i) { const int p = tid + NTHR * i, t = p >> 5, o = p & 31; *(u32x4*)(MIX + (size_t)(row0 + t) * D + 8 * o) = *(const LAS u32x4*)(ot + t * 264 + 8 * o); }
    if (n == 31) {
        for (int i = tid; i < 3 * 1536; i += NTHR) { const int r = i / 1536, col = i % 1536; a.out[O_QCP + ((size_t)(l * NBAT + b) * 3 + r) * 1536 + col] = bf2f(pseq[(size_t)(SEQ - 3 + r) * NPROJ + PC_QKV + col]); }
    }
    __syncthreads();
}

constexpr int SL_NWC = 0, SL_QG = 16384, SL_QK = 32768, SL_KT = 40960, SL_BUF = 57344, SL_O = 2 * SL_BUF, SL_OP = 272, SL_OBUF = 64 * SL_OP, SL_END = SL_O + 2 * SL_OBUF;
__device__ __forceinline__ void scan_dma(const unsigned char* pu, LAS unsigned char* buf, int wave, int lane) {
#pragma unroll
    for (int i = 0; i < 7; ++i) { const int p = wave + 8 * i; __builtin_amdgcn_global_load_lds((const unsigned*)(pu + p * 1024 + lane * 16), (LAS unsigned*)(buf + p * 1024), 16, 0, 0); }
}
__device__ __forceinline__ void scan_finalise(const LAS unsigned char* obuf, const u32x4 z0, const u32x4 z1, const f32x4 (&gn)[4], bf16* mo, int ft, int fc) {
            const u32x4 o0 = *(const LAS u32x4*)(obuf + ft * SL_OP + fc * 2), o1 = *(const LAS u32x4*)(obuf + ft * SL_OP + fc * 2 + 16);
            float ov[16], zv[16];
#pragma unroll
            for (int j = 0; j < 4; ++j) { ov[2 * j] = __uint_as_float(o0[j] << 16); ov[2 * j + 1] = __uint_as_float(o0[j] & 0xffff0000u); ov[8 + 2 * j] = __uint_as_float(o1[j] << 16); ov[8 + 2 * j + 1] = __uint_as_float(o1[j] & 0xffff0000u);
                zv[2 * j] = __uint_as_float(z0[j] << 16); zv[2 * j + 1] = __uint_as_float(z0[j] & 0xffff0000u); zv[8 + 2 * j] = __uint_as_float(z1[j] << 16); zv[8 + 2 * j + 1] = __uint_as_float(z1[j] & 0xffff0000u); }
            float ss = 0.f;
#pragma unroll
            for (int j = 0; j < 16; ++j) ss += ov[j] * ov[j];
            ss = dpp_add<0xB1>(ss); ss = dpp_add<0x4E>(ss); ss = dpp_add<0x141>(ss);
            const float rn = rsqrtf(ss * (1.f / 128.f) + EPS);
            float res[16];
#pragma unroll
            for (int j = 0; j < 16; ++j) res[j] = ov[j] * rn * gn[j >> 2][j & 3] * siluf_(zv[j]);
            u32x4 w0, w1;
#pragma unroll
            for (int j = 0; j < 4; ++j) { w0[j] = cvtpk(res[2 * j], res[2 * j + 1]); w1[j] = cvtpk(res[8 + 2 * j], res[8 + 2 * j + 1]); }
            *(u32x4*)mo = w0; *(u32x4*)(mo + 8) = w1;
}
__device__ __forceinline__ void scan_unit(const ArgsD& a, LAS unsigned char* lds, int l, int b, int h, int tid, int lane, int wave) {
    unsigned char* ws = a.ws;
    const bf16* PROJ = (const bf16*)(ws + WS_PROJ); bf16* MIX = (bf16*)(ws + WS_MIX); const float* GL = (const float*)(ws + WS_GLAST);
    const int q = lane >> 4, c = lane & 15, w = wave;
    f32x4 S[8];
#pragma unroll
    for (int m = 0; m < 8; ++m) S[m] = (f32x4){0.f, 0.f, 0.f, 0.f};
    const int ft = 8 * w + (lane >> 3), fc = 16 * (lane & 7);
    f32x4 gn[4];
#pragma unroll
    for (int j = 0; j < 4; ++j) gn[j] = *(const f32x4*)(a.in[I_DNG] + l * 128 + fc + 4 * j);
    f32x4 uaN[4]; float glN;
    {
        const int unit0 = (b * 32) * 4 + h; const unsigned char* pu0 = ws + WS_PREP + (size_t)unit0 * PREP_UNIT;
        scan_dma(pu0, lds, wave, lane);
#pragma unroll
        for (int m = 0; m < 4; ++m) uaN[m] = *(const f32x4*)(pu0 + PU_UB + ((w * 4 + m) * 64 + lane) * 16);
        glN = GL[unit0];
    }
    asm volatile("s_waitcnt vmcnt(0)" ::: "memory"); __builtin_amdgcn_s_barrier(); asm volatile("" ::: "memory");
    int offA[4], offB[2];
#pragma unroll
    for (int ks = 0; ks < 4; ++ks) offA[ks] = c * 256 + (((4 * ks + q) ^ c) << 4);
#pragma unroll
    for (int ks = 0; ks < 2; ++ks) offB[ks] = c * 128 + (((4 * ks + q) ^ (c >> 1)) << 4);
    u32x4 zp0 = (u32x4){0u, 0u, 0u, 0u}, zp1 = zp0;
    for (int n = 0; n < 32; ++n) {
        const int unit = (b * 32 + n) * 4 + h;
        const unsigned char* pu = ws + WS_PREP + (size_t)unit * PREP_UNIT;
        LAS unsigned char* buf = lds + (n & 1) * SL_BUF;
        LAS unsigned char* obuf = lds + SL_O + (n & 1) * SL_OBUF;
        f32x4 ua[4], oa[4];
#pragma unroll
        for (int m = 0; m < 4; ++m) { ua[m] = uaN[m]; oa[m] = (f32x4){0.f, 0.f, 0.f, 0.f}; }
        const float gl = glN;
        const size_t rowf = (size_t)(b * SEQ + n * 64 + ft);
        if (n + 1 < 32) {
            scan_dma(pu + (size_t)4 * PREP_UNIT, lds + ((n + 1) & 1) * SL_BUF, wave, lane);
#pragma unroll
            for (int m = 0; m < 4; ++m) uaN[m] = *(const f32x4*)(pu + (size_t)4 * PREP_UNIT + PU_UB + ((w * 4 + m) * 64 + lane) * 16);
            glN = GL[unit + 4];
        }
        const u32x4 z0_ = *(const u32x4*)(PROJ + rowf * NPROJ + PC_Z + h * 128 + fc), z1_ = *(const u32x4*)(PROJ + rowf * NPROJ + PC_Z + h * 128 + fc + 8);
        if (n > 0) scan_finalise(lds + SL_O + ((n - 1) & 1) * SL_OBUF, zp0, zp1, gn, MIX + (rowf - 64) * D + 256 + h * 128 + fc, ft, fc);
        bf16x8 Sb[4];
#pragma unroll
        for (int ks = 0; ks < 4; ++ks) Sb[ks] = pack8(S[2 * ks], S[2 * ks + 1]);
        bf16x8 fa[8], fb[8];
#define SCHED_ __builtin_amdgcn_sched_barrier(0)
#define LD_A(dst, ks) do { _Pragma("unroll") for (int m = 0; m < 4; ++m) { dst[m] = *(const LAS bf16x8*)(buf + SL_QG + m * 4096 + offA[ks]); dst[4 + m] = *(const LAS bf16x8*)(buf + SL_NWC + m * 4096 + offA[ks]); } } while (0)
#define MM_A(src, ks) do { _Pragma("unroll") for (int m = 0; m < 4; ++m) { oa[m] = MFMA16(src[m], Sb[ks], oa[m]); ua[m] = MFMA16(src[4 + m], Sb[ks], ua[m]); } } while (0)
#define LD_KT(dst, ks) do { _Pragma("unroll") for (int m = 0; m < 8; ++m) dst[m] = *(const LAS bf16x8*)(buf + SL_KT + m * 2048 + offB[ks]); } while (0)
#define MM_KT(src, ks) do { _Pragma("unroll") for (int m = 0; m < 8; ++m) S[m] = MFMA16(src[m], Ub[ks], S[m]); } while (0)
        LD_A(fa, 0); SCHED_;
        LD_A(fb, 1); SCHED_; MM_A(fa, 0); SCHED_;
        LD_A(fa, 2); SCHED_; MM_A(fb, 1); SCHED_;
        LD_A(fb, 3); SCHED_; MM_A(fa, 2); SCHED_;
#pragma unroll
        for (int ks = 0; ks < 2; ++ks)
#pragma unroll
            for (int m = 0; m < 4; ++m) fa[ks * 4 + m] = *(const LAS bf16x8*)(buf + SL_QK + m * 2048 + offB[ks]);
        SCHED_; MM_A(fb, 3); SCHED_;
        bf16x8 Ub[2];
        Ub[0] = pack8(ua[0], ua[1]); Ub[1] = pack8(ua[2], ua[3]);
        LD_KT(fb, 0); SCHED_;
#pragma unroll
        for (int ks = 0; ks < 2; ++ks)
#pragma unroll
            for (int m = 0; m < 4; ++m) oa[m] = MFMA16(fa[ks * 4 + m], Ub[ks], oa[m]);
#pragma unroll
        for (int m = 0; m < 8; ++m) S[m] = S[m] * gl;
        SCHED_;
        LD_KT(fa, 1); SCHED_; MM_KT(fb, 0); SCHED_;
        MM_KT(fa, 1); SCHED_;
#undef LD_A
#undef MM_A
#undef LD_KT
#undef MM_KT
#pragma unroll
        for (int m = 0; m < 4; ++m)
#pragma unroll
            for (int r = 0; r < 4; ++r) *(LAS bf16*)(obuf + (16 * m + 4 * q + r) * SL_OP + (16 * w + c) * 2) = f2bf(oa[m][r]);
        asm volatile("s_waitcnt vmcnt(0) lgkmcnt(0)" ::: "memory"); __builtin_amdgcn_s_barrier(); asm volatile("" ::: "memory");
        zp0 = z0_; zp1 = z1_; asm volatile("" : "+v"(zp0), "+v"(zp1));
    }
    scan_finalise(lds + SL_O + SL_OBUF, zp0, zp1, gn, MIX + (size_t)(b * SEQ + 31 * 64 + ft) * D + 256 + h * 128 + fc, ft, fc);
    float* so = a.out + O_DP + ((size_t)((l * NBAT + b) * 4 + h)) * 128 * 128;
#pragma unroll
    for (int m = 0; m < 8; ++m)
#pragma unroll
        for (int r = 0; r < 4; ++r) so[(16 * m + 4 * q + r) * 128 + 16 * w + c] = S[m][r];
    asm volatile("s_waitcnt vmcnt(0) lgkmcnt(0)" ::: "memory");
    __syncthreads();
}

__device__ __forceinline__ void sample_ac_unit(const ArgsD& a, LAS unsigned char* lds, int l, int sb, int which, int tid, int lane) {
    unsigned char* ws = a.ws;
    const int row = MP + sb; const bf16* pr = (const bf16*)(ws + WS_PROJ) + (size_t)row * NPROJ; bf16* mix = (bf16*)(ws + WS_MIX) + (size_t)row * D;
    LAS float* dv = (LAS float*)lds;
    const int half = tid >> 8, c = tid & 255;
    if (which == 0) {
        const int g = c >> 6, j = c & 63; const float* pwp = a.in[I_POOLW] + (size_t)(l * 4 + g) * 4096 + (size_t)(32 * half) * 64 + j;
        float pwv[32];
#pragma unroll
        for (int i = 0; i < 32; ++i) pwv[i] = pwp[i * 64];
        if (half == 0) {
            const float* st = a.in[I_SPOOL] + ((size_t)(l * NS + sb) * 15) * 256 + c; float* o = a.out + O_POOLS + ((size_t)(l * NS + sb) * 15) * 256 + c;
            const float u = bf2f(pr[PC_POOL + c]); const int w = 2 << (c >> 6);
            float v[15];
#pragma unroll
            for (int r = 0; r < 15; ++r) v[r] = st[r * 256];
            float s = u;
#pragma unroll
            for (int r = 0; r < 15; ++r) { if (r >= 16 - w) s += v[r]; if (r >= 1) o[(r - 1) * 256] = v[r]; }
            o[14 * 256] = u;
            dv[c] = s * __builtin_amdgcn_rcpf((float)w) - u;
        }
        __syncthreads();
        {
            float acc = 0.f;
#pragma unroll
            for (int i = 0; i < 32; ++i) acc += dv[g * 64 + 32 * half + i] * pwv[i];
            dv[256 + tid] = acc;
        }
        __syncthreads();
        if (half == 0) mix[c] = f2bf((dv[256 + c] + dv[512 + c]) * a.in[I_POOLSC][l * 256 + c]);
    } else {
        const float* pw = a.in[I_CPW] + (size_t)l * 65536 + (size_t)(128 * half) * 256 + c;
        float pw0[64];
#pragma unroll
        for (int i = 0; i < 64; ++i) pw0[i] = pw[i * 256];
        if (half == 0) {
            const float* st = a.in[I_SCONV] + ((size_t)(l * NS + sb) * 30) * 256 + c; float* o = a.out + O_CS + ((size_t)(l * NS + sb) * 30) * 256 + c;
            const float glu = bf2f(pr[PC_GLU + c]) * sigmoidf_(bf2f(pr[PC_GLU + 256 + c]));
            const float* dw = a.in[I_CDWW] + (size_t)l * 31 * 256 + c;
            float v[30], wv[31];
#pragma unroll
            for (int r = 0; r < 30; ++r) { v[r] = st[r * 256]; wv[r] = dw[r * 256]; }
            wv[30] = dw[30 * 256];
            float dc = a.in[I_CDWB][l * 256 + c] + wv[30] * glu;
#pragma unroll
            for (int r = 0; r < 30; ++r) { dc += wv[r] * v[r]; if (r >= 1) o[(r - 1) * 256] = v[r]; }
            o[29 * 256] = glu;
            const float mean = wave_sum(dc) * (1.f / 64.f); const float df = dc - mean; const float var = wave_sum(df * df) * (1.f / 64.f);
            const float dn = df * rsqrtf(var + EPS) * a.in[I_CLNG][l * 256 + c] + a.in[I_CLNB][l * 256 + c];
            dv[c] = siluf_(dn);
        }
        __syncthreads();
        {
            float pw1[64];
#pragma unroll
            for (int i = 0; i < 64; ++i) pw1[i] = pw[(64 + i) * 256];
            float acc = 0.f, acc1 = 0.f;
#pragma unroll
            for (int i = 0; i < 64; ++i) acc += dv[128 * half + i] * pw0[i];
#pragma unroll
            for (int i = 0; i < 64; ++i) acc1 += dv[128 * half + 64 + i] * pw1[i];
            dv[256 + tid] = acc + acc1;
        }
        __syncthreads();
        if (half == 0) mix[768 + c] = f2bf(dv[256 + c] + dv[512 + c]);
    }
    __syncthreads();
}
__device__ __forceinline__ void sample_delta_unit(const ArgsD& a, LAS unsigned char* lds, int l, int sb, int h, int tid, int lane, int wave) {
    unsigned char* ws = a.ws;
    const int row = MP + sb; const bf16* pr = (const bf16*)(ws + WS_PROJ) + (size_t)row * NPROJ; bf16* mix = (bf16*)(ws + WS_MIX) + (size_t)row * D;
    const float* BA = (const float*)(ws + WS_BA) + (size_t)row * 8;
    LAS float* sq = (LAS float*)lds;
    LAS float* scal = sq + 384; LAS float* part = sq + 400; LAS float* osq = sq + 1424;
    const int dq = tid >> 7, dvi = tid & 127;
    const float* Sin = a.in[I_SDELTA] + ((size_t)((l * NS + sb) * 4 + h)) * 16384 + (size_t)(32 * dq) * 128 + dvi;
    float s[32];
#pragma unroll
    for (int i = 0; i < 32; ++i) s[i] = Sin[i * 128];
    const float ba_b = BA[h], ba_a = BA[4 + h], dtb = a.in[I_DTB][l * 4 + h], alog = a.in[I_ALOG][l * 4 + h];
    const float zraw = bf2f(pr[PC_Z + h * 128 + dvi]), dng = a.in[I_DNG][l * 128 + dvi];
    if (tid < 384) {
        const int s = tid >> 7, c = tid & 127, wcol = s * 512 + h * 128 + c;
        const float* st = a.in[I_SQKV] + ((size_t)(l * NS + sb) * 3) * 1536 + wcol; float* o = a.out + O_QCS + ((size_t)(l * NS + sb) * 3) * 1536 + wcol;
        const float* cw = a.in[I_QKVW] + (size_t)l * 4 * 1536 + wcol;
        const float x0 = st[0], x1 = st[1536], x2 = st[2 * 1536], x3 = bf2f(pr[PC_QKV + wcol]);
        o[0] = x1; o[1536] = x2; o[2 * 1536] = x3;
        sq[tid] = siluf_((cw[0] * x0 + cw[1536] * x1) + (cw[2 * 1536] * x2 + cw[3 * 1536] * x3));
    }
    __syncthreads();
    if (wave == 0) {
        const float q0 = sq[lane], q1 = sq[64 + lane], k0 = sq[128 + lane], k1 = sq[192 + lane];
        const float ssq = wave_sum(q0 * q0 + q1 * q1), ssk = wave_sum(k0 * k0 + k1 * k1), qk = wave_sum(q0 * k0 + q1 * k1);
        if (lane == 0) { const float rq = rsqrtf(ssq + EPS) * 0.08838834764831845f, rk = rsqrtf(ssk + EPS);
            const float beta = sigmoidf_(ba_b); const float xg = ba_a + dtb; const float sp = softplusf_(xg);
            const float g = -__expf(alog) * sp;
            scal[0] = rq; scal[1] = rk; scal[2] = qk * rq * rk; scal[3] = beta; scal[4] = __expf(g); }
    }
    __syncthreads();
    const float rq = scal[0], rk = scal[1], qkd = scal[2], beta = scal[3], eg = scal[4];
    float ks = 0.f, qs = 0.f;
#pragma unroll
    for (int i = 0; i < 32; ++i) { ks += sq[128 + 32 * dq + i] * s[i]; qs += sq[32 * dq + i] * s[i]; }
    part[dq * 128 + dvi] = ks * rk; part[512 + dq * 128 + dvi] = qs * rq;
    __syncthreads();
    const float kS = (part[dvi] + part[128 + dvi]) + (part[256 + dvi] + part[384 + dvi]);
    const float qS = (part[512 + dvi] + part[640 + dvi]) + (part[768 + dvi] + part[896 + dvi]);
    const float u = beta * (sq[256 + dvi] - eg * kS);
    const float o = eg * qS + qkd * u;
    float* So = a.out + O_DS + ((size_t)((l * NS + sb) * 4 + h)) * 16384 + (size_t)(32 * dq) * 128 + dvi;
#pragma unroll
    for (int i = 0; i < 32; ++i) So[i * 128] = eg * s[i] + (sq[128 + 32 * dq + i] * rk) * u;
    if (dq == 0) { const float t = wave_sum(o * o); if (lane == 0) osq[wave] = t; }
    __syncthreads();
    if (dq == 0) { const float ss = osq[0] + osq[1];
        mix[256 + h * 128 + dvi] = f2bf(o * rsqrtf(ss * (1.f / 128.f) + EPS) * dng * siluf_(zraw)); }
    __syncthreads();
}


struct EpiSBf16 { bf16* O; int ldc; int act;
    __device__ __forceinline__ void operator()(const f32x4& v, int row0, int col) const {
#pragma unroll
        for (int r = 0; r < 4; ++r) { float x = v[r]; if (act == 2) { x = fmaxf(x, 0.f); x = x * x; } O[(size_t)(row0 + r) * ldc + col] = f2bf(x); } } };
struct EpiSResid { float* X; const float* gate;
    __device__ __forceinline__ void operator()(const f32x4& v, int row0, int col) const {
#pragma unroll
        for (int r = 0; r < 4; ++r) { const int row = row0 + r; float* xp = X + (size_t)row * D + col; *xp = *xp + gate[(size_t)(NBAT + row) * MODW + col] * v[r]; } } };
template <int KS, int K, class Epi>
__device__ __forceinline__ void skinny_unit(const bf16* A, int lda, const bf16* Bt, int ct, int rg, const Epi& E, LAS unsigned char* lds, int tid, int lane, int wave) {
    constexpr int RT = 8 / KS, NB = K / 256, KLEN = K / KS, NF = KLEN / 32;
    static_assert(NF == 32, "skinny_unit: K / KS must be 1024");
    const int rtl = wave % RT, kp = wave / RT, rt = rg * RT + rtl;
    const int q = lane >> 4, c = lane & 15;
    u32x4 bst[NB];
#pragma unroll
    for (int i = 0; i < NB; ++i) { const int p = tid + NTHR * i, col = p / (K / 8), chunk = p % (K / 8); bst[i] = *(const u32x4*)(Bt + (size_t)(ct * 16 + col) * K + chunk * 8); }
    const bf16* ap = A + (size_t)(rt * 16 + c) * lda + kp * KLEN + q * 8;
    bf16x8 a0[16], a1[16];
#pragma unroll
    for (int j = 0; j < 16; ++j) a0[j] = *(const bf16x8*)(ap + j * 32);
#pragma unroll
    for (int i = 0; i < NB; ++i) { const int p = tid + NTHR * i, col = p / (K / 8), chunk = p % (K / 8); *(LAS u32x4*)(lds + (chunk * 16 + col) * 16) = bst[i]; }
#pragma unroll
    for (int j = 0; j < 16; ++j) a1[j] = *(const bf16x8*)(ap + (16 + j) * 32);
    __syncthreads();
    f32x4 acc0 = (f32x4){0.f, 0.f, 0.f, 0.f}, acc1 = (f32x4){0.f, 0.f, 0.f, 0.f};
    const LAS unsigned char* bl = lds + ((kp * (KLEN / 8) + q) * 16 + c) * 16;
#pragma unroll
    for (int j = 0; j < 16; j += 2) { acc0 = MFMA16(a0[j], *(const LAS bf16x8*)(bl + j * 1024), acc0); acc1 = MFMA16(a0[j + 1], *(const LAS bf16x8*)(bl + (j + 1) * 1024), acc1); }
#pragma unroll
    for (int j = 0; j < 16; j += 2) { acc0 = MFMA16(a1[j], *(const LAS bf16x8*)(bl + (16 + j) * 1024), acc0); acc1 = MFMA16(a1[j + 1], *(const LAS bf16x8*)(bl + (17 + j) * 1024), acc1); }
    f32x4 acc = acc0 + acc1;
    if (KS > 1) {
        LAS float* red = (LAS float*)(lds + 131072);
        *(LAS f32x4*)(red + (wave * 64 + lane) * 4) = acc;
        __syncthreads();
        if (kp == 0) {
#pragma unroll
            for (int p = 1; p < KS; ++p) acc = acc + *(const LAS f32x4*)(red + ((p * RT + rtl) * 64 + lane) * 4);
            E(acc, rt * 16 + 4 * q, ct * 16 + c);
        }
    } else {
        E(acc, rt * 16 + 4 * q, ct * 16 + c);
    }
    __syncthreads();
}
__device__ __forceinline__ void sub_barrier(unsigned* cnt, unsigned nwg) {
    asm volatile("s_waitcnt vmcnt(0) lgkmcnt(0)" ::: "memory");
    __syncthreads();
    if (threadIdx.x == 0) {
        __builtin_amdgcn_fence(__ATOMIC_RELEASE, "agent");
        asm volatile("s_waitcnt vmcnt(0)" ::: "memory");
        __hip_atomic_fetch_add(cnt, 1u, __ATOMIC_RELAXED, __HIP_MEMORY_SCOPE_AGENT);
        unsigned spins = 0;
        while (__hip_atomic_load(cnt, __ATOMIC_RELAXED, __HIP_MEMORY_SCOPE_AGENT) < nwg) { __builtin_amdgcn_s_sleep(1); if (++spins > (1u << 22)) break; }
        __builtin_amdgcn_fence(__ATOMIC_ACQUIRE, "agent");
        asm volatile("s_waitcnt vmcnt(0)" ::: "memory");
    }
    __syncthreads();
}
__device__ __forceinline__ void norm_row(const float* xr, const float* gvec, const float* mp, bf16* orow, int lane) {
    f32x4 v[4]; float s = 0.f;
#pragma unroll
    for (int j = 0; j < 4; ++j) { v[j] = *(const f32x4*)(xr + 4 * lane + 256 * j); s += (v[j][0] * v[j][0] + v[j][1] * v[j][1]) + (v[j][2] * v[j][2] + v[j][3] * v[j][3]); }
    const float rinv = rsqrtf(wave_sum(s) * (1.f / D) + EPS);
    u32x2* o8 = (u32x2*)orow + lane;
#pragma unroll
    for (int j = 0; j < 4; ++j) { const f32x4 g4 = *(const f32x4*)(gvec + 4 * lane + 256 * j), sh = *(const f32x4*)(mp + 4 * lane + 256 * j), sc = *(const f32x4*)(mp + D + 4 * lane + 256 * j);
        const f32x4 h = v[j] * rinv * g4 * (sc + 1.f) + sh; o8[64 * j] = (u32x2){cvtpk(h[0], h[1]), cvtpk(h[2], h[3])}; }
}
#ifndef MK_PER_PHASE
#define MK_PER_PHASE 0
#endif

#ifdef NO_PREP
#define KNOB_PREP(x)
#else
#define KNOB_PREP(x) x
#endif
#ifdef NO_CONF
#define KNOB_CONF(x)
#else
#define KNOB_CONF(x) x
#endif
#ifdef NO_SCAN
#define KNOB_SCAN(x)
#else
#define KNOB_SCAN(x) x
#endif
#ifdef NO_SAC
#define KNOB_SAC(x)
#else
#define KNOB_SAC(x) x
#endif
#ifdef NO_SD
#define KNOB_SD(x)
#else
#define KNOB_SD(x) x
#endif

#define RLX_AGENT __ATOMIC_RELAXED, __HIP_MEMORY_SCOPE_AGENT
#define XB_TMO      128
#define XB_XCNT(j)  (256  + 64 * (j))
#define XB_XSUB(j)  (1280 + 64 * (j))
#define XB_XGEN(j)  (2304 + 64 * (j))
#define XB_TOP      3328
#define XB_TOPGEN   3392
#define XCD_BAR_WORDS 3456
#define XB_SPIN_CAP (1u << 18)

__device__ __forceinline__ unsigned xb_ld(unsigned* p)              { return __hip_atomic_load(p, __ATOMIC_RELAXED, __HIP_MEMORY_SCOPE_AGENT); }
__device__ __forceinline__ unsigned xb_add(unsigned* p, unsigned v) { return __hip_atomic_fetch_add(p, v, __ATOMIC_RELAXED, __HIP_MEMORY_SCOPE_AGENT); }
__device__ __forceinline__ unsigned xb_xcc_id() { return (unsigned)__builtin_amdgcn_s_getreg((3 << 11) | 20) & 0xFu; }
#define XB_SPIN(cond, bar) do { unsigned _sp = 0; while (cond) { __builtin_amdgcn_s_sleep(1); \
    if ((++_sp & 255u) == 0u) { if (xb_ld(&(bar)[XB_TMO])) break; if (_sp > XB_SPIN_CAP) { atomicAdd(&(bar)[XB_TMO], 1u); break; } } } } while (0)

struct XcdBarrier {
    unsigned* bar; unsigned x;
    volatile LAS unsigned* st;
};

__device__ __forceinline__ XcdBarrier xcd_barrier_post(unsigned* bar, volatile LAS unsigned* st) {
    XcdBarrier b; b.bar = bar; b.x = xb_xcc_id(); b.st = st;
    if (threadIdx.x == 0) (void)xb_add(&bar[XB_XCNT(b.x)], 1u);
    return b;
}
__device__ __forceinline__ void xcd_barrier_complete(unsigned* bar, unsigned x, unsigned& nloc, unsigned& nx) {
    const unsigned G = gridDim.x * gridDim.y * gridDim.z;
    unsigned sum, cnt, mine, sp = 0u;
    for (;;) {
        sum = 0u; cnt = 0u; mine = 0u;
#pragma unroll
        for (unsigned j = 0; j < 16; ++j) { const unsigned c = xb_ld(&bar[XB_XCNT(j)]); sum += c; cnt += (c > 0u) ? 1u : 0u; mine = (j == x) ? c : mine; }
        if (sum == G) break;
        __builtin_amdgcn_s_sleep(1);
        if ((++sp & 255u) == 0u) { if (xb_ld(&bar[XB_TMO])) break; if (sp > XB_SPIN_CAP) { atomicAdd(&bar[XB_TMO], 1u); break; } }
    }
    nloc = mine > 0u ? mine : 1u; nx = cnt > 0u ? cnt : 1u;
}

__device__ __forceinline__ void xcd_barrier(const XcdBarrier& b) {
    asm volatile("s_waitcnt vmcnt(0)" ::: "memory");
    __syncthreads();
    if (threadIdx.x == 0) {
        unsigned* bar = b.bar;
        __builtin_amdgcn_s_waitcnt(0);
        unsigned nloc = b.st[0], nx = b.st[1];
        if (nloc == 0u) { xcd_barrier_complete(bar, b.x, nloc, nx); b.st[0] = nloc; b.st[1] = nx; }
        const unsigned old = xb_add(&bar[XB_XSUB(b.x)], 1u);
        const unsigned gen = old / nloc;
        if (old + 1u == (gen + 1u) * nloc) {
            __builtin_amdgcn_fence(__ATOMIC_RELEASE, "agent");
            asm volatile("s_waitcnt vmcnt(0)" ::: "memory");
            const unsigned og = xb_add(&bar[XB_TOP], 1u);
            const unsigned tg = og / nx;
            if (og + 1u == (tg + 1u) * nx) xb_add(&bar[XB_TOPGEN], 1u);
            else XB_SPIN(xb_ld(&bar[XB_TOPGEN]) == tg, bar);
            __builtin_amdgcn_fence(__ATOMIC_ACQUIRE, "agent");
            xb_add(&bar[XB_XGEN(b.x)], 1u);
            asm volatile("s_waitcnt vmcnt(0)" ::: "memory");
        } else {
            XB_SPIN(xb_ld(&bar[XB_XGEN(b.x)]) == gen, bar);
            __builtin_amdgcn_fence(__ATOMIC_ACQUIRE, "agent");
            asm volatile("s_waitcnt vmcnt(0)" ::: "memory");
        }
    }
    __syncthreads();
}

__device__ __attribute__((noinline)) void xcd_barrier_subset(unsigned* bar, volatile LAS unsigned* st, unsigned total) {
    asm volatile("s_waitcnt vmcnt(0)" ::: "memory");
    __syncthreads();
    if (threadIdx.x == 0) {
        __builtin_amdgcn_s_waitcnt(0);
        const unsigned x = xb_xcc_id();
        unsigned nloc = st[0], nx = st[1];
        if (nloc == 0u) {
            unsigned sum, cnt, mine, sp = 0u;
            for (;;) {
                sum = 0u; cnt = 0u; mine = 0u;
#pragma unroll
                for (unsigned j = 0; j < 16; ++j) { const unsigned c = xb_ld(&bar[XB_XCNT(j)]); sum += c; cnt += (c > 0u) ? 1u : 0u; mine = (j == x) ? c : mine; }
                if (sum == total) break;
                __builtin_amdgcn_s_sleep(1);
                if ((++sp & 255u) == 0u) { if (xb_ld(&bar[XB_TMO])) break; if (sp > XB_SPIN_CAP) { atomicAdd(&bar[XB_TMO], 1u); break; } }
            }
            nloc = mine > 0u ? mine : 1u; nx = cnt > 0u ? cnt : 1u; st[0] = nloc; st[1] = nx;
        }
        const unsigned old = xb_add(&bar[XB_XSUB(x)], 1u);
        const unsigned gen = old / nloc;
        if (old + 1u == (gen + 1u) * nloc) {
            __builtin_amdgcn_fence(__ATOMIC_RELEASE, "agent");
            asm volatile("s_waitcnt vmcnt(0)" ::: "memory");
            const unsigned og = xb_add(&bar[XB_TOP], 1u);
            const unsigned tg = og / nx;
            if (og + 1u == (tg + 1u) * nx) xb_add(&bar[XB_TOPGEN], 1u);
            else XB_SPIN(xb_ld(&bar[XB_TOPGEN]) == tg, bar);
            __builtin_amdgcn_fence(__ATOMIC_ACQUIRE, "agent");
            xb_add(&bar[XB_XGEN(x)], 1u);
            asm volatile("s_waitcnt vmcnt(0)" ::: "memory");
        } else {
            XB_SPIN(xb_ld(&bar[XB_XGEN(x)]) == gen, bar);
            __builtin_amdgcn_fence(__ATOMIC_ACQUIRE, "agent");
            asm volatile("s_waitcnt vmcnt(0)" ::: "memory");
        }
    }
    __syncthreads();
}
__device__ __forceinline__ void gsync_(cg::grid_group& grid) { asm volatile("s_waitcnt vmcnt(0) lgkmcnt(0)" ::: "memory"); grid.sync(); }
constexpr int N_PHASES = 34;
__global__ void __launch_bounds__(NTHR, 2) __attribute__((amdgpu_waves_per_eu(2, 2))) hybrid_fwd(Args args_k) {
    extern __shared__ __attribute__((aligned(16))) unsigned char lds_raw[];
    LAS unsigned char* lds = (LAS unsigned char*)lds_raw;
    cg::grid_group grid = cg::this_grid();
    if (args_k.ph_hi > 4096) grid.sync();
    const int G = gridDim.x;
#define FRESH_IDS() int tid = threadIdx.x; asm volatile("" : "+v"(tid)); const int lane = tid & 63, wave = __builtin_amdgcn_readfirstlane(tid >> 6); (void)lane; (void)wave;
    unsigned char* ws = args_k.ws;
    const int lo = args_k.ph_lo, hi = args_k.ph_hi; (void)lo; (void)hi;
    volatile LAS unsigned* xst = (volatile LAS unsigned*)(lds + LDS_BYTES - 16);
    volatile LAS unsigned* ptbl = (volatile LAS unsigned*)(lds + LDS_BYTES - 512);
    if (threadIdx.x < 4) xst[threadIdx.x] = 0u;
    if (threadIdx.x < N_INPUTS) { const unsigned long long pv = (unsigned long long)args_k.in[threadIdx.x]; ptbl[2 * threadIdx.x] = (unsigned)pv; ptbl[2 * threadIdx.x + 1] = (unsigned)(pv >> 32); }
    __syncthreads();
#if USE_LDS_PTRS
    const ArgsD args{{(const LAS unsigned*)ptbl}, args_k.out, args_k.ws};
#else
    const Args& args = args_k;
#endif
    XcdBarrier xbar = xcd_barrier_post((unsigned*)(ws + WS_CTL) + 4096, xst);
    if (blockIdx.x >= 32 && threadIdx.x == 0) (void)xb_add((unsigned*)(ws + WS_CTL) + 16384 + XB_XCNT(xbar.x), 1u);
#define IN(k) (lo <= (k) && (k) < hi)
#ifndef DUP_MASK
#define DUP_MASK 0
#endif
#ifndef DUP_PM
#define DUP_PM 31
#endif
#ifndef DUP_P2
#define DUP_P2 15
#endif
#ifndef DUP_CHAIN
#define DUP_CHAIN 15
#endif
#ifndef DUP_SKIP_SCAN
#define DUP_SKIP_SCAN 0
#endif
#ifndef DUP_SKIP_SAMPLE
#define DUP_SKIP_SAMPLE 0
#endif
#define REP(bit) for (int rep_ = 0; rep_ <= ((DUP_MASK >> (bit)) & 1); ++rep_) if (rep_ ? (xcd_barrier(xbar), true) : true)
#define SEAM(k) do { if (IN(k) && IN((k) + 1)) xcd_barrier(xbar); } while (0)
#ifdef EXTRA_SYNCS
    for (int es_ = 0; es_ < EXTRA_SYNCS; ++es_) xcd_barrier(xbar);
#endif
    if (IN(0)) REP(8) { FRESH_IDS(); phase_p0a(args, lds, tid, lane, wave, G); __syncthreads(); }
    SEAM(0);
    if (IN(1)) REP(9) { FRESH_IDS(); phase_p0b(args, tid, lane, wave, G); }
    SEAM(1);
    for (int l = 0; l < DEPTH; ++l) {
        const int pb = 2 + 8 * l;
        const float* MODL = (const float*)(ws + WS_MOD) + (size_t)l * NMOD * MODW;
        if (IN(pb + 0)) REP(0) { FRESH_IDS(); if (l == 0) phase_norm<true, true>(args, lds, l, 0, args.in[I_G1] + l * D, MT, tid, lane, wave, G); else phase_norm<false, true>(args, lds, l, 0, args.in[I_G1] + l * D, MT, tid, lane, wave, G); }
        SEAM(pb + 0);
        if (IN(pb + 1)) REP(1) {
            { pg8::Gemm g{(const bf16*)(ws + WS_XN), (const bf16*)(ws + WS_WIN + l * WIN_L), MP, NPROJ, D}; pg8::StaticOrder S; S.init(MP, NPROJ, G, (int)blockIdx.x);
              pg8::EpiBf16<0> E{(bf16*)(ws + WS_PROJ), NPROJ};
              pg8::gemm_phase<pg8::EpiBf16<0>, pg8::StaticOrder, true, true>(lds, g, S, E); }
            { FRESH_IDS();
              constexpr int nun = (MP / 256) * (NPROJ / 256); const int rounds = (nun + G - 1) / G; int first_light = nun - (rounds - 1) * G; if (first_light >= G) first_light = 0;
              if ((int)blockIdx.x >= first_light) { const int nl = G - first_light; const EpiSBf16 E{(bf16*)(ws + WS_PROJ) + (size_t)MP * NPROJ, NPROJ, 0};
                  for (int u = (int)blockIdx.x - first_light; u < NPROJ / 16; u += nl) skinny_unit<1, D>((const bf16*)(ws + WS_XN) + (size_t)MP * D, D, (const bf16*)(ws + WS_WIN + l * WIN_L), u, 0, E, lds, tid, lane, wave); } }
        }
        SEAM(pb + 1);
        if (IN(pb + 2)) REP(2) {
            for (int k_ = 0; k_ < 1536 / 256; ++k_) { const int kk_ = (k_ + (int)(blockIdx.x % 6)) % 6; const int u = (int)blockIdx.x + 256 * kk_;
                if (u < 512) { if (!rep_ || (DUP_P2 & 1)) { FRESH_IDS(); prep_unit(args, lds, l, u >> 6, (u >> 1) & 31, u & 1, tid, lane); } }
                else if (u < 768) { if (!rep_ || (DUP_P2 & 2)) { const int v = u - 512; FRESH_IDS(); KNOB_CONF(confpool_unit(args, lds, l, v >> 5, v & 31, tid, lane, wave)); } }
                else if (u < 1024) { if (!rep_ || (DUP_P2 & 4)) { FRESH_IDS(); KNOB_SAC(sample_ac_unit(args, lds, l, (u - 768) >> 1, (u - 768) & 1, tid, lane)); } }
                else { if (!rep_ || (DUP_P2 & 8)) { FRESH_IDS(); KNOB_SD(sample_delta_unit(args, lds, l, (u - 1024) >> 2, (u - 1024) & 3, tid, lane, wave)); } }
            }
        }
        SEAM(pb + 2);
        if (IN(pb + 3)) REP(3) {
            const int bid = blockIdx.x;
            if (bid < 32) { if (!(rep_ && DUP_SKIP_SCAN)) { FRESH_IDS(); KNOB_SCAN(scan_unit(args, lds, l, bid >> 2, bid & 3, tid, lane, wave)); } }
            else if (!(rep_ && DUP_SKIP_SAMPLE)) {
                FRESH_IDS();
                const int nch = G - 32, ci = bid - 32;
                const bf16* xns = (const bf16*)(ws + WS_XN) + (size_t)MP * D; float* xs = rep_ ? (float*)(ws + WS_SCR) : (float*)(ws + WS_XS); bf16* hs = (bf16*)(ws + WS_HS);
                if (!rep_ || (DUP_CHAIN & 1)) { const EpiSResid E{xs, MODL + 2 * D};
                  for (int u = ci; u < D / 16; u += nch) skinny_unit<1, D>((const bf16*)(ws + WS_MIX) + (size_t)MP * D, D, (const bf16*)(ws + WS_WOUT + l * WOUT_L), u, 0, E, lds, tid, lane, wave); }
                xcd_barrier_subset((unsigned*)(ws + WS_CTL) + 16384, xst + 2, (unsigned)nch);
                if (!rep_ || (DUP_CHAIN & 2)) for (int r = ci * NWAVES + wave; r < NS; r += nch * NWAVES) norm_row(xs + (size_t)r * D, args.in[I_G2] + l * D, MODL + (size_t)(NBAT + r) * MODW + 3 * D, (bf16*)(ws + WS_XN) + (size_t)(MP + r) * D, lane);
                xcd_barrier_subset((unsigned*)(ws + WS_CTL) + 16384, xst + 2, (unsigned)nch);
                if (!rep_ || (DUP_CHAIN & 4)) { const EpiSBf16 E{hs, FF, 2};
                  for (int u = ci; u < FF / 16; u += nch) skinny_unit<1, D>(xns, D, (const bf16*)(ws + WS_W1 + l * W1_L), u, 0, E, lds, tid, lane, wave); }
                xcd_barrier_subset((unsigned*)(ws + WS_CTL) + 16384, xst + 2, (unsigned)nch);
                if (!rep_ || (DUP_CHAIN & 8)) { const EpiSResid E{xs, MODL + 5 * D};
                  for (int u = ci; u < (D / 16) * 4; u += nch) skinny_unit<4, FF>(hs, FF, (const bf16*)(ws + WS_W2 + l * W2_L), u >> 2, u & 3, E, lds, tid, lane, wave); }
                if (l + 1 < DEPTH && !rep_) p0a_weights(args, lds, l + 1, ci * NWAVES + wave, nch * NWAVES, lane, wave);
            }
        }
        SEAM(pb + 3);
        if (IN(pb + 4)) {
            pg8::Gemm g{(const bf16*)(ws + WS_MIX), (const bf16*)(ws + WS_WOUT + l * WOUT_L), MP, D, D}; pg8::StaticOrder S; S.init(MP, D, G, (int)blockIdx.x);
            pg8::Unit u0; u0.pm = 0; u0.pn = 0; S.next(0, u0);
            pg8::EpiResidNorm<0> E{(bf16*)(ws + WS_X), MODL + 2 * D, args.in[I_G2] + l * D, MODL + 3 * D, (bf16*)(ws + WS_XN), nullptr,
                                   (unsigned*)(ws + WS_XCH) + (size_t)l * MP * 4, (unsigned*)(ws + WS_CTL) + 8192 + (l * 64 + u0.pm) * 16};
            pg8::gemm_phase<pg8::EpiResidNorm<0>, pg8::StaticOrder, false, true>(lds, g, S, E);
        }
        SEAM(pb + 4);
        if (IN(pb + 6)) REP(6) {
            pg8::Gemm g{(const bf16*)(ws + WS_XN), (const bf16*)(ws + WS_W1 + l * W1_L), MP, FF, D}; pg8::StaticOrder S; S.init(MP, FF, G, (int)blockIdx.x);
            pg8::EpiBf16<2, true> E{(bf16*)(ws + WS_H), FF};
            pg8::gemm_phase<pg8::EpiBf16<2, true>, pg8::StaticOrder, true, true>(lds, g, S, E);
        }
        SEAM(pb + 6);
        if (IN(pb + 7)) {
            pg8::Gemm g{(const bf16*)(ws + WS_H), (const bf16*)(ws + WS_W2 + l * W2_L), MP, D, FF}; pg8::StaticOrder S; S.init(MP, D, G, (int)blockIdx.x);
            if (l < DEPTH - 1) { pg8::EpiResid E{(bf16*)(ws + WS_X), MODL + 5 * D};
                pg8::gemm_phase<pg8::EpiResid, pg8::StaticOrder, true, true>(lds, g, S, E); }
            else {
                { FRESH_IDS(); (void)tid; phase_final(args, lane, wave, G); }
                pg8::Unit u0; u0.pm = 0; u0.pn = 0; S.next(0, u0);
                pg8::EpiResidNorm<1> E{(bf16*)(ws + WS_X), MODL + 5 * D, args.in[I_GF], nullptr, nullptr, args.out + O_YP,
                                       (unsigned*)(ws + WS_XCH) + (size_t)4 * MP * 4, (unsigned*)(ws + WS_CTL) + 8192 + (4 * 64 + u0.pm) * 16};
                pg8::gemm_phase<pg8::EpiResidNorm<1>, pg8::StaticOrder, false, true>(lds, g, S, E); }
        }
        SEAM(pb + 7);
    }
#undef IN
#undef SEAM
}

extern "C" void kernel_launch(void* const* d_in, const int* in_sizes, int n_in, void* d_out, int out_size, void* d_ws, size_t ws_size, hipStream_t stream) {
    static int grid = 0;
    if (grid == 0) {
        if (n_in != N_INPUTS || (size_t)out_size != O_END || ws_size < WS_END) { fprintf(stderr, "kernel_launch: unexpected shapes: n_in %d out %d ws %zu (need %zu)\n", n_in, out_size, ws_size, (size_t)WS_END); grid = -1; return; }
        int dev = 0, cus = 0, per_cu = 0;
        if (hipGetDevice(&dev) != hipSuccess || hipDeviceGetAttribute(&cus, hipDeviceAttributeMultiprocessorCount, dev) != hipSuccess) { grid = -1; return; }
        if (hipFuncSetAttribute((const void*)hybrid_fwd, hipFuncAttributeMaxDynamicSharedMemorySize, LDS_BYTES) != hipSuccess) { fprintf(stderr, "kernel_launch: hipFuncSetAttribute failed\n"); grid = -1; return; }
        if (hipOccupancyMaxActiveBlocksPerMultiprocessor(&per_cu, (const void*)hybrid_fwd, NTHR, LDS_BYTES) != hipSuccess || per_cu < 1) { fprintf(stderr, "kernel_launch: occupancy query failed (%d)\n", per_cu); (void)hipGetLastError(); per_cu = 1; }
        if (per_cu > 1) per_cu = 1;
        grid = cus * per_cu;
    }
    if (grid != 256) { if (grid >= 0) fprintf(stderr, "kernel_launch: grid %d: this build needs exactly 256 resident workgroups (one per CU)\n", grid); return; }
    if (hipMemsetAsync((char*)d_ws + WS_CTL, 0, 131072, stream) != hipSuccess) { fprintf(stderr, "kernel_launch: memset failed\n"); return; }
    Args a{};
    for (int i = 0; i < N_INPUTS; ++i) a.in[i] = (const float*)d_in[i];
    a.out = (float*)d_out; a.ws = (unsigned char*)d_ws;
#if MK_PER_PHASE
    for (int p = 0; p < N_PHASES; ++p) {
        a.ph_lo = p; a.ph_hi = p + 1;
        void* kargs[] = {&a};
        hipError_t e = hipLaunchCooperativeKernel((const void*)hybrid_fwd, dim3(grid), dim3(NTHR), kargs, LDS_BYTES, stream);
        if (e != hipSuccess) { fprintf(stderr, "kernel_launch: launch of phase %d failed: %s\n", p, hipGetErrorString(e)); break; }
    }
#else
    a.ph_lo = 0; a.ph_hi = N_PHASES;
    void* kargs[] = {&a};
    hipError_t e = hipLaunchCooperativeKernel((const void*)hybrid_fwd, dim3(grid), dim3(NTHR), kargs, LDS_BYTES, stream);
    if (e != hipSuccess) fprintf(stderr, "kernel_launch: cooperative launch failed: %s (grid %d)\n", hipGetErrorString(e), grid);
#endif
}
```
